# Optimizing an MI355X kernel written in HIP

```python
import jax
import jax.numpy as jnp
from jax import lax
import numpy as np

D_MODEL = 1024
BATCH = 32
SEQ = 2048
DEPTH = 2

GRID_W = 64
CTX_LEN = 256
N_MIXERS = 2
N_RET_LAYERS = (DEPTH + N_MIXERS - 1) // N_MIXERS
N_ATT_LAYERS = DEPTH // N_MIXERS
N_MOD = 6
NORM_EPS = 1e-6
HEAD_NORM_EPS = 1e-5
ROPE_THETA = 10000.0

RET_HEADS = 4
RET_DK = D_MODEL // RET_HEADS
RET_DV = 2 * RET_DK
RET_QK = RET_HEADS * RET_DK
RET_V = RET_HEADS * RET_DV
RET_QKV = 2 * RET_QK + RET_V
RET_IN = RET_QKV + RET_V
RET_CHUNK = 128

ATT_HEAD_DIM = 128
ATT_Q_HEADS = D_MODEL // ATT_HEAD_DIM
ATT_KV_HEADS = 2
ATT_GROUP = ATT_Q_HEADS // ATT_KV_HEADS
ATT_QW = ATT_Q_HEADS * ATT_HEAD_DIM
ATT_KW = ATT_KV_HEADS * ATT_HEAD_DIM
ATT_IN = ATT_QW + 2 * ATT_KW
Q_BLOCK = 128

N_GROUPS = 4
EXPERTS_PER_GROUP = 8
N_EXPERTS = N_GROUPS * EXPERTS_PER_GROUP
TOP_K_IN_GROUP = 2
EXPERT_HIDDEN = D_MODEL // 2
EXPERT_BLOCK = 256

kernel_name = "hybrid_retention_gqa_hmoe_dit"


def rms_norm(x, eps=NORM_EPS):
    xf = x.astype(jnp.float32)
    return (xf * lax.rsqrt(jnp.mean(xf * xf, axis=-1, keepdims=True) + eps)).astype(x.dtype)


def head_norm(y):
    yf = y.astype(jnp.float32)
    mu = jnp.mean(yf, axis=-1, keepdims=True)
    var = jnp.mean(jnp.square(yf - mu), axis=-1, keepdims=True)
    return ((yf - mu) * lax.rsqrt(var + HEAD_NORM_EPS)).astype(y.dtype)


def modulate(x, shift, scale):
    return rms_norm(x) * (1 + scale) + shift


def axial_rope_tables(n, head_dim, dtype):
    rows = n // GRID_W
    r = jnp.repeat(jnp.arange(rows), GRID_W).astype(jnp.float32)
    col = jnp.tile(jnp.arange(GRID_W), rows).astype(jnp.float32)
    nf = head_dim // 4
    inv = ROPE_THETA ** (-jnp.arange(nf, dtype=jnp.float32) / nf)
    ar = r[:, None] * inv
    ac = col[:, None] * inv
    ang = jnp.concatenate([ar, ar, ac, ac], axis=-1)
    return jnp.cos(ang).astype(dtype), jnp.sin(ang).astype(dtype)


def rotate_half(u):
    a, b = jnp.split(u, 2, axis=-1)
    return jnp.concatenate([-b, a], axis=-1)


def apply_axial_rope(x, cos, sin):
    half = x.shape[-1] // 2
    x_rot = jnp.concatenate([rotate_half(x[..., :half]), rotate_half(x[..., half:])], axis=-1)
    return x * cos[:, None, :] + x_rot * sin[:, None, :]


def chunk_retention(q, k, v, log_g, state0, with_output):
    B, H, T, dk = q.shape
    dv = v.shape[-1]
    C = RET_CHUNK
    n = T // C
    lg = log_g.astype(jnp.float32)
    pos = jnp.arange(C, dtype=jnp.float32)
    zeta = jnp.exp(lg[:, None] * (C - 1 - pos))
    chunk_decay = jnp.exp(lg * C)
    qc = q.reshape(B, H, n, C, dk)
    kc = k.reshape(B, H, n, C, dk)
    vc = v.reshape(B, H, n, C, dv)
    kz = kc * zeta[:, None, :, None].astype(k.dtype)

    def step(state, xs):
        q_i, kz_i, v_i = xs
        cross = jnp.einsum('bhcd,bhde->bhce', q_i.astype(jnp.float32), state) if with_output else None
        upd = jnp.einsum('bhcd,bhce->bhde', kz_i, v_i).astype(jnp.float32)
        return state * chunk_decay[:, None, None] + upd, cross

    final_state, crosses = lax.scan(
        step, state0, (jnp.moveaxis(qc, 2, 0), jnp.moveaxis(kz, 2, 0), jnp.moveaxis(vc, 2, 0)))
    if not with_output:
        return final_state, None
    diff = pos[:, None] - pos[None, :]
    dmask = jnp.where(diff >= 0, jnp.exp(lg[:, None, None] * jnp.maximum(diff, 0.0)), 0.0)
    scores = jnp.einsum('bhnid,bhnjd->bhnij', qc, kc) * dmask[:, None].astype(q.dtype)
    inner = jnp.einsum('bhnij,bhnje->bhnie', scores, vc)
    xi = jnp.exp(lg[:, None] * (pos + 1))
    cross = (jnp.moveaxis(crosses, 0, 2) * xi[:, None, :, None]).astype(v.dtype)
    return final_state, (inner + cross).reshape(B, H, T, dv)


def _ret_project(u, w_in, with_gate):
    B, n, _ = u.shape
    p = u @ (w_in if with_gate else w_in[:, :RET_QKV])
    q = p[..., :RET_QK].reshape(B, n, RET_HEADS, RET_DK)
    k = p[..., RET_QK:2 * RET_QK].reshape(B, n, RET_HEADS, RET_DK) * (RET_DK ** -0.5)
    v = p[..., 2 * RET_QK:RET_QKV].reshape(B, n, RET_HEADS, RET_DV)
    g = p[..., RET_QKV:] if with_gate else None
    return q, k, v, g


def retention_mixer(h, hc, w_in, w_out, log_g_fwd, log_g_bwd, need_ctx):
    B, S, _ = h.shape
    L = hc.shape[1]
    q, k, v, g = _ret_project(h, w_in, True)
    cos, sin = axial_rope_tables(S, RET_DK, h.dtype)
    q = apply_axial_rope(q, cos, sin)
    k = apply_axial_rope(k, cos, sin)
    qc, kc, vc, gc = _ret_project(hc, w_in, need_ctx)
    to_bhtd = lambda u: u.transpose(0, 2, 1, 3)
    flip = lambda u: jnp.flip(u, axis=2)
    q, k, v = to_bhtd(q), to_bhtd(k), to_bhtd(v)
    qc, kc, vc = to_bhtd(qc), to_bhtd(kc), to_bhtd(vc)
    zero = jnp.zeros((B, RET_HEADS, RET_DK, RET_DV), jnp.float32)
    st_f, yc_f = chunk_retention(qc, kc, vc, log_g_fwd, zero, need_ctx)
    st_b, yc_b = chunk_retention(flip(qc), flip(kc), flip(vc), log_g_bwd, zero, need_ctx)
    _, y_f = chunk_retention(q, k, v, log_g_fwd, st_f, True)
    _, y_b = chunk_retention(flip(q), flip(k), flip(v), log_g_bwd, st_b, True)

    def finish(y, gate, n):
        y = head_norm(y).transpose(0, 2, 1, 3).reshape(B, n, RET_V)
        return (y * jax.nn.silu(gate)) @ w_out

    out = finish(y_f + flip(y_b), g, S)
    out_c = finish(yc_f + flip(yc_b), gc, L) if need_ctx else None
    return out, out_c


def _att_project(u, w_qkv, q_gain, k_gain, with_q):
    B, n, _ = u.shape
    p = u @ (w_qkv if with_q else w_qkv[:, ATT_QW:])
    if with_q:
        q = rms_norm(p[..., :ATT_QW].reshape(B, n, ATT_Q_HEADS, ATT_HEAD_DIM)) * q_gain
        p = p[..., ATT_QW:]
    else:
        q = None
    k = rms_norm(p[..., :ATT_KW].reshape(B, n, ATT_KV_HEADS, ATT_HEAD_DIM)) * k_gain
    v = p[..., ATT_KW:].reshape(B, n, ATT_KV_HEADS, ATT_HEAD_DIM)
    return q, k, v


def gqa_softmax(q, k, v):
    B, nq = q.shape[0], q.shape[1]
    qg = q.reshape(B, nq, ATT_KV_HEADS, ATT_GROUP, ATT_HEAD_DIM)
    s = jnp.einsum('bqkgd,bskd->bkgqs', qg, k).astype(jnp.float32) * (ATT_HEAD_DIM ** -0.5)
    p = jax.nn.softmax(s, axis=-1).astype(v.dtype)
    o = jnp.einsum('bkgqs,bskd->bqkgd', p, v)
    return o.reshape(B, nq, ATT_QW)


def blocked_attention(q, k, v):
    B, S = q.shape[0], q.shape[1]
    nb = S // Q_BLOCK
    qb = jnp.moveaxis(q.reshape(B, nb, Q_BLOCK, ATT_Q_HEADS, ATT_HEAD_DIM), 1, 0)
    o = lax.map(lambda qi: gqa_softmax(qi, k, v), qb)
    return jnp.moveaxis(o, 0, 1).reshape(B, S, ATT_QW)


def attention_mixer(h, hc, w_qkv, w_o, q_gain, k_gain, need_ctx):
    S = h.shape[1]
    q, k, v = _att_project(h, w_qkv, q_gain, k_gain, True)
    cos, sin = axial_rope_tables(S, ATT_HEAD_DIM, h.dtype)
    q = apply_axial_rope(q, cos, sin)
    k = apply_axial_rope(k, cos, sin)
    qc, kc, vc = _att_project(hc, w_qkv, q_gain, k_gain, need_ctx)
    k_all = jnp.concatenate([k, kc], axis=1)
    v_all = jnp.concatenate([v, vc], axis=1)
    out = blocked_attention(q, k_all, v_all) @ w_o
    out_c = gqa_softmax(qc, kc, vc) @ w_o if need_ctx else None
    return out, out_c


def grouped_expert_ffn(h, expert_ids, gates, w_gate, w_up, w_down):
    T, D = h.shape
    K = expert_ids.shape[1]
    A = T * K
    flat_e = expert_ids.reshape(A)
    order = jnp.argsort(flat_e)
    sorted_e = flat_e[order]
    counts = jnp.bincount(flat_e, length=N_EXPERTS)
    starts = jnp.cumsum(counts) - counts
    padded = (counts + EXPERT_BLOCK - 1) // EXPERT_BLOCK * EXPERT_BLOCK
    ends_p = jnp.cumsum(padded)
    starts_p = ends_p - padded
    dest = starts_p[sorted_e] + (jnp.arange(A) - starts[sorted_e])
    n_blocks = -(-A // EXPERT_BLOCK) + N_EXPERTS
    slot_tok = jnp.full((n_blocks * EXPERT_BLOCK,), T, dtype=jnp.int32).at[dest].set(
        (order // K).astype(jnp.int32))
    block_e = jnp.minimum(
        jnp.searchsorted(ends_p, jnp.arange(n_blocks) * EXPERT_BLOCK, side='right'), N_EXPERTS - 1)
    h_pad = jnp.concatenate([h, jnp.zeros((1, D), h.dtype)], axis=0)

    def run_block(args):
        toks, e = args
        xb = h_pad[toks]
        return (jax.nn.silu(xb @ w_gate[e]) * (xb @ w_up[e])) @ w_down[e]

    y_slots = lax.map(run_block, (slot_tok.reshape(n_blocks, EXPERT_BLOCK), block_e))
    y_sorted = y_slots.reshape(-1, D)[dest]
    y_assign = jnp.zeros_like(y_sorted).at[order].set(y_sorted).reshape(T, K, D)
    return jnp.sum(y_assign * gates[..., None].astype(h.dtype), axis=1)


def hier_moe(h, w_group, b_group, w_expert, b_expert, w_gate, w_up, w_down):
    T = h.shape[0]
    glog = (h @ w_group).astype(jnp.float32) + b_group.astype(jnp.float32)
    gprob = jax.nn.softmax(glog, axis=-1)
    g_idx = jnp.argmax(glog, axis=-1)
    g_p = jnp.take_along_axis(gprob, g_idx[:, None], axis=-1)
    elog = ((h @ w_expert).astype(jnp.float32) + b_expert.astype(jnp.float32)).reshape(
        T, N_GROUPS, EXPERTS_PER_GROUP)
    elog = jnp.take_along_axis(elog, g_idx[:, None, None], axis=1)[:, 0]
    top_p, top_e = lax.top_k(jax.nn.softmax(elog, axis=-1), TOP_K_IN_GROUP)
    gates = g_p * top_p / jnp.sum(top_p, axis=-1, keepdims=True)
    expert_ids = g_idx[:, None] * EXPERTS_PER_GROUP + top_e
    return grouped_expert_ffn(h, expert_ids, gates, w_gate, w_up, w_down)


def setup_inputs(seed: int = 0) -> dict:
    key = jax.random.key(seed)
    ks = jax.random.split(key, 22)
    f32 = jnp.float32
    D = D_MODEL

    def normal(k, shape, scale):
        return jax.random.normal(k, shape, f32) * scale

    heads = jnp.arange(RET_HEADS, dtype=f32)
    base_log_decay = jnp.log1p(-(2.0 ** (-5.0 - heads)))
    return {
        'x': normal(ks[0], (BATCH, SEQ, D), 1.0),
        'c': normal(ks[1], (BATCH, D), 1.0),
        'ctx': normal(ks[2], (BATCH, CTX_LEN, D), 1.0),
        'c_ctx': normal(ks[3], (D,), 1.0),
        'w_mod': normal(ks[4], (DEPTH, D, N_MOD * D), 0.5 * D ** -0.5),
        'b_mod': normal(ks[5], (DEPTH, N_MOD * D), 0.02),
        'ret_w_in': normal(ks[6], (N_RET_LAYERS, D, RET_IN), D ** -0.5),
        'ret_w_out': normal(ks[7], (N_RET_LAYERS, RET_V, D), RET_V ** -0.5),
        'ret_log_decay_fwd': base_log_decay[None] * (1.0 + 0.05 * normal(ks[8], (N_RET_LAYERS, RET_HEADS), 1.0)),
        'ret_log_decay_bwd': base_log_decay[None] * (1.0 + 0.05 * normal(ks[9], (N_RET_LAYERS, RET_HEADS), 1.0)),
        'att_w_qkv': normal(ks[10], (N_ATT_LAYERS, D, ATT_IN), D ** -0.5),
        'att_w_o': normal(ks[11], (N_ATT_LAYERS, ATT_QW, D), ATT_QW ** -0.5),
        'att_q_gain': 1.0 + normal(ks[12], (N_ATT_LAYERS, ATT_HEAD_DIM), 0.02),
        'att_k_gain': 1.0 + normal(ks[13], (N_ATT_LAYERS, ATT_HEAD_DIM), 0.02),
        'moe_w_group': normal(ks[14], (DEPTH, D, N_GROUPS), D ** -0.5),
        'moe_b_group': normal(ks[15], (DEPTH, N_GROUPS), 0.01),
        'moe_w_expert': normal(ks[16], (DEPTH, D, N_EXPERTS), D ** -0.5),
        'moe_b_expert': normal(ks[17], (DEPTH, N_EXPERTS), 0.01),
        'moe_w_gate': normal(ks[18], (DEPTH, N_EXPERTS, D, EXPERT_HIDDEN), D ** -0.5),
        'moe_w_up': normal(ks[19], (DEPTH, N_EXPERTS, D, EXPERT_HIDDEN), D ** -0.5),
        'moe_w_down': normal(ks[20], (DEPTH, N_EXPERTS, EXPERT_HIDDEN, D), EXPERT_HIDDEN ** -0.5),
        'final_norm_gain': 1.0 + normal(ks[21], (D,), 0.02),
    }


def reference(x, c, ctx, c_ctx, w_mod, b_mod, ret_w_in, ret_w_out, ret_log_decay_fwd,
              ret_log_decay_bwd, att_w_qkv, att_w_o, att_q_gain, att_k_gain, moe_w_group,
              moe_b_group, moe_w_expert, moe_b_expert, moe_w_gate, moe_w_up, moe_w_down,
              final_norm_gain):
    B, S, D = x.shape
    L = ctx.shape[1]
    xc = ctx
    for i in range(DEPTH):
        need_ctx = i < DEPTH - 1
        j = i // N_MIXERS
        m = jax.nn.silu(c) @ w_mod[i] + b_mod[i]
        mc = jax.nn.silu(c_ctx) @ w_mod[i] + b_mod[i]
        sh1, sc1, g1, sh2, sc2, g2 = jnp.split(m[:, None, :], N_MOD, axis=-1)
        csh1, csc1, cg1, csh2, csc2, cg2 = jnp.split(mc, N_MOD, axis=-1)
        h = modulate(x, sh1, sc1)
        hc = modulate(xc, csh1, csc1)
        if i % N_MIXERS == 0:
            y, yc = retention_mixer(h, hc, ret_w_in[j], ret_w_out[j], ret_log_decay_fwd[j],
                                    ret_log_decay_bwd[j], need_ctx)
        else:
            y, yc = attention_mixer(h, hc, att_w_qkv[j], att_w_o[j], att_q_gain[j],
                                    att_k_gain[j], need_ctx)
        x = x + g1 * y
        h2 = modulate(x, sh2, sc2)
        moe_args = (moe_w_group[i], moe_b_group[i], moe_w_expert[i], moe_b_expert[i],
                    moe_w_gate[i], moe_w_up[i], moe_w_down[i])
        if need_ctx:
            xc = xc + cg1 * yc
            h2c = modulate(xc, csh2, csc2)
            f = hier_moe(jnp.concatenate([h2.reshape(B * S, D), h2c.reshape(B * L, D)], axis=0), *moe_args)
            x = x + g2 * f[:B * S].reshape(B, S, D)
            xc = xc + cg2 * f[B * S:].reshape(B, L, D)
        else:
            x = x + g2 * hier_moe(h2.reshape(B * S, D), *moe_args).reshape(B, S, D)
    return rms_norm(x) * final_norm_gain
```

```cpp
#include <hip/hip_runtime.h>
#include <cstdio>
#include <cstdint>
#define MK_PER_PHASE 0
namespace pg8 {
#define PG8_LAS __attribute__((address_space(3)))
typedef unsigned short bf16_t;
typedef short bf16x8 __attribute__((ext_vector_type(8)));
typedef float f32x4 __attribute__((ext_vector_type(4)));
typedef unsigned u32x4 __attribute__((ext_vector_type(4)));
constexpr int BM = 256, BK = 64, HALF = 128, HTB = HALF * BK * 2  , STAGE_BYTES = 8 * HTB, NXCD = 8, WGM = 8;

__host__ __device__ __forceinline__ int lds_byte(int r, int c) { const int st = (r >> 4) * 2 + (c >> 5), rr = r & 15, cc = c & 31, ob = rr * 64 + cc * 2; return st * 1024 + (ob ^ (((ob >> 9) & 1) << 5)); }
__host__ __device__ __forceinline__ void stage_rc(int b, int& R, int& C) { const int st = b / 1024, sb = b % 1024, swz = sb ^ (((sb >> 9) & 1) << 5); R = (st >> 1) * 16 + swz / 64; C = (st & 1) * 32 + (swz % 64) / 2; }
__host__ __device__ __forceinline__ int perm32(int rho) { const int n = rho >> 4, i = rho & 15; return 8 * (i >> 2) + 4 * n + (i & 3); }

struct Unit { int pm, pn; };
struct Gemm { const bf16_t* A; const bf16_t* Bt; int M, N, K; const int* rowidx = nullptr; };

struct StaticOrder {
    int nM, nN, nwg, G, c;
    __host__ __device__ void init(int M, int N, int G_, int c_) { nM = M / BM; nN = N / BM; nwg = nM * nN; G = G_; c = c_; }
    __host__ __device__ bool next(int i, Unit& u) const {
        const long L = (long)i * G + c; if (L >= nwg) return false;
        int wgid = (int)L; { const int q = nwg / NXCD, r = nwg % NXCD, xcd = wgid % NXCD, off = wgid / NXCD; wgid = (xcd < r ? xcd * (q + 1) : r * (q + 1) + (xcd - r) * q) + off; }
        const int nig = WGM * nN, gid = wgid / nig, fm = gid * WGM, gsz = (nM - fm) < WGM ? (nM - fm) : WGM;
        u.pm = fm + ((wgid % nig) % gsz); u.pn = (wgid % nig) / gsz; return true;
    }
    __device__ __forceinline__ void a_ready(const Unit&) const {}
    __device__ __forceinline__ void done(const Unit&) const {}
};

__device__ __forceinline__ unsigned cvt_pk_bf16(float lo, float hi) { unsigned r; asm volatile("v_cvt_pk_bf16_f32 %0, %1, %2" : "=v"(r) : "v"(lo), "v"(hi)); return r; }
typedef float f32x2 __attribute__((ext_vector_type(2)));
__device__ __forceinline__ f32x2 gelu_pk(f32x2 v) {
    const f32x2 av = __builtin_elementwise_abs(v), d = av * 0.2316418882f + 1.0f;
    f32x2 t; t.x = __builtin_amdgcn_rcpf(d.x); t.y = __builtin_amdgcn_rcpf(d.y);
    f32x2 q = t * 0.5307027145f + (-0.7265760135f); q = q * t + 0.7107068705f; q = q * t + (-0.142248368f); q = q * t + 0.127414796f; q = q * t;
    const f32x2 s = (v * v) * (-0.72134752044f);
    f32x2 e; e.x = __builtin_amdgcn_exp2f(s.x); e.y = __builtin_amdgcn_exp2f(s.y);
    const f32x2 m = v * (q * e), r = v - m;
    f32x2 o; o.x = v.x < 0.f ? m.x : r.x; o.y = v.y < 0.f ? m.y : r.y; return o;
}

template <int ACT  > struct EpiBf16 {
    static constexpr bool PERM = true, AFTER_DRAIN = false; static_assert(ACT == 0 || ACT == 1, "EpiBf16: ACT is 0 (none) or 1 (gelu_pk)");
    bf16_t* O; int ldc; const float* bias; int split_cols; size_t split_stride; float scale0;
    __device__ __forceinline__ void operator()(const f32x4 (&acc)[2][2][4][2], const Unit& u, int wr, int wc, int fr, int fq) const {
        const int row0 = u.pm * BM + wr * 64 + fr; int colt = u.pn * BM; bf16_t* base = O;
        float sc = 1.f; if (split_cols) { const int t = colt / split_cols; base += (size_t)t * split_stride; colt -= t * split_cols; if (t == 0) sc = scale0; }
        const int col0 = colt + wc * 32 + 8 * fq, bcol0 = u.pn * BM + wc * 32 + 8 * fq;
        f32x4 bv[2][2];
#pragma unroll
        for (int bj = 0; bj < 2; ++bj)
#pragma unroll
            for (int n = 0; n < 2; ++n) bv[bj][n] = bias ? *(const f32x4*)(bias + bcol0 + bj * HALF + 4 * n) : (f32x4){0.f, 0.f, 0.f, 0.f};
#pragma unroll
        for (int ai = 0; ai < 2; ++ai)
#pragma unroll
            for (int m = 0; m < 4; ++m) { bf16_t* rowp = base + (size_t)(row0 + ai * HALF + m * 16) * ldc + col0;
#pragma unroll
                for (int bj = 0; bj < 2; ++bj) { f32x4 v0 = acc[ai][bj][m][0] + bv[bj][0], v1 = acc[ai][bj][m][1] + bv[bj][1];
                    if (ACT == 1) { f32x2 a = gelu_pk((f32x2){v0[0], v0[1]}), b = gelu_pk((f32x2){v0[2], v0[3]}), c = gelu_pk((f32x2){v1[0], v1[1]}), d = gelu_pk((f32x2){v1[2], v1[3]});
                        v0 = (f32x4){a.x, a.y, b.x, b.y}; v1 = (f32x4){c.x, c.y, d.x, d.y}; }
                    v0 = v0 * sc; v1 = v1 * sc; u32x4 w; w.x = cvt_pk_bf16(v0[0], v0[1]); w.y = cvt_pk_bf16(v0[2], v0[3]); w.z = cvt_pk_bf16(v1[0], v1[1]); w.w = cvt_pk_bf16(v1[2], v1[3]);
                    *(u32x4*)(rowp + bj * HALF) = w; } }
    }
};
struct EpiStoreBf16 {
    static constexpr bool PERM = true, AFTER_DRAIN = false;
    bf16_t* O; int ldc; int pnmask;
    __device__ __forceinline__ void operator()(const f32x4 (&acc)[2][2][4][2], const Unit& u, int wr, int wc, int fr, int fq) const {
        const int row0 = u.pm * BM + wr * 64 + fr, col0 = (u.pn & pnmask) * BM + wc * 32 + 8 * fq;
#pragma unroll
        for (int ai = 0; ai < 2; ++ai)
#pragma unroll
            for (int m = 0; m < 4; ++m) { bf16_t* rowp = O + (size_t)(row0 + ai * HALF + m * 16) * ldc + col0;
#pragma unroll
                for (int bj = 0; bj < 2; ++bj) { const f32x4 v0 = acc[ai][bj][m][0], v1 = acc[ai][bj][m][1];
                    u32x4 w; w.x = cvt_pk_bf16(v0[0], v0[1]); w.y = cvt_pk_bf16(v0[2], v0[3]); w.z = cvt_pk_bf16(v1[0], v1[1]); w.w = cvt_pk_bf16(v1[2], v1[3]);
                    *(u32x4*)(rowp + bj * HALF) = w; } }
    }
};
struct EpiStoreF32 {
    static constexpr bool PERM = false, AFTER_DRAIN = false;
    float* C; int ldc; int pnmask;
    __device__ __forceinline__ void operator()(const f32x4 (&acc)[2][2][4][2], const Unit& u, int wr, int wc, int fr, int fq) const {
        const int row0 = u.pm * BM + wr * 64 + fr, col0 = (u.pn & pnmask) * BM + wc * 32 + 4 * fq;
#pragma unroll
        for (int ai = 0; ai < 2; ++ai)
#pragma unroll
            for (int m = 0; m < 4; ++m) { float* rowp = C + (size_t)(row0 + ai * HALF + m * 16) * ldc + col0;
#pragma unroll
                for (int bj = 0; bj < 2; ++bj)
#pragma unroll
                    for (int n = 0; n < 2; ++n) *(f32x4*)(rowp + bj * HALF + n * 16) = acc[ai][bj][m][n]; }
    }
};
struct GroupedOrder {
    const int* tile_e; int n_units, G, c;
    __device__ __forceinline__ void init(const int* tile_tab, int G_, int c_) { n_units = tile_tab[0] * 4; tile_e = tile_tab + 1; G = G_; c = c_; }
    __device__ __forceinline__ bool next(int i, Unit& u) const {
        const long L = (long)i * G + c; if (L >= n_units) return false;
        const int pm = (int)(L >> 2); u.pm = pm; u.pn = tile_e[pm] * 4 + (int)(L & 3); return true;
    }
    __device__ __forceinline__ void a_ready(const Unit&) const {}
    __device__ __forceinline__ void done(const Unit&) const {}
};

struct EpiSwiGLU {
    static constexpr bool PERM = true, AFTER_DRAIN = false;
    bf16_t* O; int ldc; int pnmask;
    __device__ __forceinline__ void operator()(const f32x4 (&acc)[2][2][4][2], const Unit& u, int wr, int wc, int fr, int fq) const {
        const int row0 = u.pm * BM + wr * 64 + fr, col0 = (u.pn & pnmask) * 128 + wc * 16 + 4 * fq;
#pragma unroll
        for (int ai = 0; ai < 2; ++ai)
#pragma unroll
            for (int m = 0; m < 4; ++m) { bf16_t* rowp = O + (size_t)(row0 + ai * HALF + m * 16) * ldc + col0;
#pragma unroll
                for (int bj = 0; bj < 2; ++bj) { const f32x4 g = acc[ai][bj][m][0], up = acc[ai][bj][m][1]; float h[4];
#pragma unroll
                    for (int i = 0; i < 4; ++i) h[i] = g[i] * __builtin_amdgcn_rcpf(1.0f + __builtin_amdgcn_exp2f(-1.4426950408889634f * g[i])) * up[i];
                    typedef unsigned u32x2_t __attribute__((ext_vector_type(2))); u32x2_t w; w.x = cvt_pk_bf16(h[0], h[1]); w.y = cvt_pk_bf16(h[2], h[3]);
                    *(u32x2_t*)(rowp + bj * 64) = w; } }
    }
};
template <bool PUB = false> struct EpiResidT {
    static constexpr bool PERM = false, AFTER_DRAIN = false;
    const float* s_lat; const float* s_ctx; float* d_lat; float* d_ctx; const float* mod; int gate_off; int tile0;
    __device__ __forceinline__ void operator()(const f32x4 (&acc)[2][2][4][2], const Unit& u, int wr, int wc, int fr, int fq) const {
        const int tile = tile0 + u.pm, b = tile / 9, st = tile - 9 * b;
        const size_t rbase = st == 0 ? (size_t)b * 256 : (size_t)b * 2048 + (size_t)(st - 1) * 256;
        const float* src = (st == 0 ? s_ctx : s_lat) + rbase * 1024; float* dst = (st == 0 ? d_ctx : d_lat) + rbase * 1024;
        const float* gp = mod + (size_t)(st == 0 ? 32 : b) * 6144 + gate_off;
        const int r0 = wr * 64 + fr, col0 = u.pn * BM + wc * 32 + 4 * fq;
        f32x4 gv[2][2];
#pragma unroll
        for (int bj = 0; bj < 2; ++bj)
#pragma unroll
            for (int n = 0; n < 2; ++n) gv[bj][n] = *(const f32x4*)(gp + col0 + bj * HALF + n * 16);
#pragma unroll
        for (int ai = 0; ai < 2; ++ai) { f32x4 xv[4][2][2];
#pragma unroll
            for (int m = 0; m < 4; ++m) { const size_t off = (size_t)(r0 + ai * HALF + m * 16) * 1024 + col0;
#pragma unroll
                for (int bj = 0; bj < 2; ++bj)
#pragma unroll
                    for (int n = 0; n < 2; ++n) xv[m][bj][n] = *(const f32x4*)(src + off + bj * HALF + n * 16); }
#pragma unroll
            for (int m = 0; m < 4; ++m) { const size_t off = (size_t)(r0 + ai * HALF + m * 16) * 1024 + col0;
#pragma unroll
                for (int bj = 0; bj < 2; ++bj)
#pragma unroll
                    for (int n = 0; n < 2; ++n) { const f32x4 ov = xv[m][bj][n] + gv[bj][n] * acc[ai][bj][m][n]; float* dp = dst + off + bj * HALF + n * 16;
                        if constexpr (PUB) asm volatile("global_store_dwordx4 %0, %1, off sc1" :: "v"(dp), "v"(ov) : "memory"); else *(f32x4*)dp = ov; } } }
    }
};
typedef EpiResidT<false> EpiResid;
template <int MODE> struct PanelOrder {
    int G, c; unsigned* cnt;
    static __device__ __forceinline__ int tile_of(int p) { return MODE == 0 ? p : 9 * (p >> 3) + 1 + (p & 7); }
    static __device__ __forceinline__ int panel_of(int pm) { return MODE == 0 ? pm : (pm / 9) * 8 + (pm % 9) - 1; }
    static constexpr int NPANEL = MODE == 0 ? 288 : 256;
    __device__ __forceinline__ void init(int G_, int c_, unsigned* cnt_) { G = G_; c = c_; cnt = cnt_; }
    __device__ __forceinline__ bool next(int i, Unit& u) const {
        const long L = (long)i * G + c; if (L >= NPANEL * 4) return false;
        u.pm = tile_of((int)(L >> 2)); u.pn = (int)(L & 3); return true;
    }
    __device__ __forceinline__ void a_ready(const Unit&) const {}
    __device__ __forceinline__ void done(const Unit& u) const {
        asm volatile("s_waitcnt vmcnt(0)" ::: "memory");
        if ((threadIdx.x & 63) == 0) __hip_atomic_fetch_add(cnt + 64 * panel_of(u.pm), 1u, __ATOMIC_RELAXED, __HIP_MEMORY_SCOPE_AGENT);
    }
};

struct LatentOrder {
    int G, c;
    __device__ __forceinline__ void init(int G_, int c_) { G = G_; c = c_; }
    __device__ __forceinline__ bool next(int i, Unit& u) const {
        const long L = (long)i * G + c; if (L >= 256 * 4) return false;
        const int lt = (int)(L >> 2); u.pm = 9 * (lt >> 3) + 1 + (lt & 7); u.pn = (int)(L & 3); return true;
    }
    __device__ __forceinline__ void a_ready(const Unit&) const {}
    __device__ __forceinline__ void done(const Unit&) const {}
};

struct EpiHeadGate {
    static constexpr bool PERM = true, AFTER_DRAIN = false;
    const bf16_t* Y; const float* PS; bf16_t* O;
    __device__ __forceinline__ void operator()(const f32x4 (&acc)[2][2][4][2], const Unit& u, int wr, int wc, int fr, int fq) const {
        const int row0 = u.pm * BM + wr * 64 + fr, col0 = u.pn * BM + wc * 32 + 8 * fq, hh = u.pn >> 1;
#pragma unroll
        for (int ai = 0; ai < 2; ++ai) { f32x4 pav[4], pbv[4]; u32x4 yvv[4][2];
#pragma unroll
            for (int m = 0; m < 4; ++m) { const size_t r = (size_t)(row0 + ai * HALF + m * 16);
                pav[m] = *(const f32x4*)(PS + ((r * 4 + hh) * 4) * 2); pbv[m] = *(const f32x4*)(PS + ((r * 4 + hh) * 4) * 2 + 4);
#pragma unroll
                for (int bj = 0; bj < 2; ++bj) yvv[m][bj] = *(const u32x4*)(Y + r * 2048 + col0 + bj * HALF); }
#pragma unroll
            for (int m = 0; m < 4; ++m) { const size_t r = (size_t)(row0 + ai * HALF + m * 16);
                const f32x4 pa = pav[m], pb = pbv[m];
                const float mu = ((pa[0] + pa[2]) + (pb[0] + pb[2])) * (1.0f / 512.0f), ex2 = ((pa[1] + pa[3]) + (pb[1] + pb[3])) * (1.0f / 512.0f);
                const float rstd = __builtin_amdgcn_rsqf(fmaxf(ex2 - mu * mu, 0.f) + 1e-5f);
#pragma unroll
                for (int bj = 0; bj < 2; ++bj) { const u32x4 yv = yvv[m][bj];
                    const float y[8] = {__builtin_bit_cast(float, yv.x << 16), __builtin_bit_cast(float, yv.x & 0xffff0000u), __builtin_bit_cast(float, yv.y << 16), __builtin_bit_cast(float, yv.y & 0xffff0000u),
                                        __builtin_bit_cast(float, yv.z << 16), __builtin_bit_cast(float, yv.z & 0xffff0000u), __builtin_bit_cast(float, yv.w << 16), __builtin_bit_cast(float, yv.w & 0xffff0000u)};
                    float o[8];
#pragma unroll
                    for (int i = 0; i < 8; ++i) { const float gt = acc[ai][bj][m][i >> 2][i & 3]; o[i] = (y[i] - mu) * rstd * gt * __builtin_amdgcn_rcpf(1.0f + __builtin_amdgcn_exp2f(-1.4426950408889634f * gt)); }
                    u32x4 w; w.x = cvt_pk_bf16(o[0], o[1]); w.y = cvt_pk_bf16(o[2], o[3]); w.z = cvt_pk_bf16(o[4], o[5]); w.w = cvt_pk_bf16(o[6], o[7]);
                    *(u32x4*)(O + r * 2048 + col0 + bj * HALF) = w; } } }
    }
};
struct EpiRopeQKV {
    static constexpr bool PERM = true, AFTER_DRAIN = false;
    bf16_t* O; const float* TR; int tile0;
    __device__ __forceinline__ void operator()(const f32x4 (&acc)[2][2][4][2], const Unit& u, int wr, int wc, int fr, int fq) const {
        const int tile = tile0 + u.pm, b = tile / 9, st = tile - 9 * b, region = u.pn >> 2;
        const int row0 = u.pm * BM + wr * 64 + fr, col0 = u.pn * BM + wc * 32 + 8 * fq;
        const float sc = region == 1 ? 0.0625f : 1.0f; const bool rot = region < 2 && st != 0;
        const int j0 = (wc * 32 + 8 * fq) >> 1;
        f32x4 tca[2], tcb[2], tma[4], tmb[4];
#pragma unroll
        for (int ai = 0; ai < 2; ++ai) { const int pos = st == 0 ? 0 : 4 * (st - 1) + 2 * ai + wr; tca[ai] = *(const f32x4*)(TR + (pos * 64 + j0) * 2); tcb[ai] = *(const f32x4*)(TR + (pos * 64 + j0) * 2 + 4); }
#pragma unroll
        for (int m = 0; m < 4; ++m) { const int pos = 16 * m + fr; tma[m] = *(const f32x4*)(TR + (pos * 64 + j0) * 2); tmb[m] = *(const f32x4*)(TR + (pos * 64 + j0) * 2 + 4); }
        __builtin_amdgcn_s_waitcnt(0x0F70);
#pragma unroll
        for (int ai = 0; ai < 2; ++ai)
#pragma unroll
            for (int m = 0; m < 4; ++m) { bf16_t* rowp = O + (size_t)(row0 + ai * HALF + m * 16) * 4096 + col0;
#pragma unroll
                for (int bj = 0; bj < 2; ++bj) { f32x4 v0 = acc[ai][bj][m][0], v1 = acc[ai][bj][m][1];
                    if (rot) { const f32x4 ca = bj ? tma[m] : tca[ai], cb = bj ? tmb[m] : tcb[ai];
                        const f32x4 a0 = v0, a1 = v1;
                        v0[0] = a0[0] * ca[0] - a0[1] * ca[1]; v0[1] = a0[1] * ca[0] + a0[0] * ca[1]; v0[2] = a0[2] * ca[2] - a0[3] * ca[3]; v0[3] = a0[3] * ca[2] + a0[2] * ca[3];
                        v1[0] = a1[0] * cb[0] - a1[1] * cb[1]; v1[1] = a1[1] * cb[0] + a1[0] * cb[1]; v1[2] = a1[2] * cb[2] - a1[3] * cb[3]; v1[3] = a1[3] * cb[2] + a1[2] * cb[3]; }
                    v0 = v0 * sc; v1 = v1 * sc;
                    u32x4 w; w.x = cvt_pk_bf16(v0[0], v0[1]); w.y = cvt_pk_bf16(v0[2], v0[3]); w.z = cvt_pk_bf16(v1[0], v1[1]); w.w = cvt_pk_bf16(v1[2], v1[3]);
                    *(u32x4*)(rowp + bj * HALF) = w; } }
        (void)b;
    }
};

struct EpiScatterBf16 {
    static constexpr bool PERM = true, AFTER_DRAIN = false;
    bf16_t* O; const int* drow; int pnmask;
    __device__ __forceinline__ void operator()(const f32x4 (&acc)[2][2][4][2], const Unit& u, int wr, int wc, int fr, int fq) const {
        const int row0 = u.pm * BM + wr * 64 + fr, col0 = (u.pn & pnmask) * BM + wc * 32 + 8 * fq;
        int dr[2][4];
#pragma unroll
        for (int ai = 0; ai < 2; ++ai)
#pragma unroll
            for (int m = 0; m < 4; ++m) dr[ai][m] = drow[row0 + ai * HALF + m * 16];
#pragma unroll
        for (int ai = 0; ai < 2; ++ai)
#pragma unroll
            for (int m = 0; m < 4; ++m) { bf16_t* rowp = O + (size_t)dr[ai][m] * 1024 + col0;
#pragma unroll
                for (int bj = 0; bj < 2; ++bj) { const f32x4 v0 = acc[ai][bj][m][0], v1 = acc[ai][bj][m][1];
                    u32x4 w; w.x = cvt_pk_bf16(v0[0], v0[1]); w.y = cvt_pk_bf16(v0[2], v0[3]); w.z = cvt_pk_bf16(v1[0], v1[1]); w.w = cvt_pk_bf16(v1[2], v1[3]);
                    *(u32x4*)(rowp + bj * HALF) = w; } }
    }
};

struct EpiQKNorm {
    static constexpr bool PERM = true, AFTER_DRAIN = false;
    bf16_t* O; const float* TA; const float* qgain; const float* kgain; PG8_LAS float* xl;
    __device__ __forceinline__ void operator()(const f32x4 (&acc)[2][2][4][2], const Unit& u, int wr, int wc, int fr, int fq) const {
        const int b = u.pm / 9, st = u.pm - 9 * b;
        const int row0 = u.pm * BM + wr * 64 + fr, col0 = u.pn * BM + wc * 32 + 8 * fq;
        if (u.pn >= 5) {
#pragma unroll
            for (int ai = 0; ai < 2; ++ai)
#pragma unroll
                for (int m = 0; m < 4; ++m) { bf16_t* rowp = O + (size_t)(row0 + ai * HALF + m * 16) * 1536 + col0;
#pragma unroll
                    for (int bj = 0; bj < 2; ++bj) { const f32x4 v0 = acc[ai][bj][m][0], v1 = acc[ai][bj][m][1];
                        u32x4 w; w.x = cvt_pk_bf16(v0[0], v0[1]); w.y = cvt_pk_bf16(v0[2], v0[3]); w.z = cvt_pk_bf16(v1[0], v1[1]); w.w = cvt_pk_bf16(v1[2], v1[3]);
                        *(u32x4*)(rowp + bj * HALF) = w; } }
            return; }
#pragma unroll
        for (int ai = 0; ai < 2; ++ai)
#pragma unroll
            for (int m = 0; m < 4; ++m)
#pragma unroll
                for (int bj = 0; bj < 2; ++bj) { const f32x4 v0 = acc[ai][bj][m][0], v1 = acc[ai][bj][m][1];
                    float s = (v0[0] * v0[0] + v0[1] * v0[1]) + (v0[2] * v0[2] + v0[3] * v0[3]) + (v1[0] * v1[0] + v1[1] * v1[1]) + (v1[2] * v1[2] + v1[3] * v1[3]);
                    s += __shfl_xor(s, 16); s += __shfl_xor(s, 32);
                    if (fq == 0) xl[((ai * HALF + wr * 64 + m * 16 + fr) * 2 + bj) * 4 + wc] = s; }
        asm volatile("s_waitcnt lgkmcnt(0)" ::: "memory"); __builtin_amdgcn_s_barrier(); asm volatile("" ::: "memory");
        const float* gn = (u.pn < 4 ? qgain : kgain) + wc * 32 + 8 * fq;
        const f32x4 g0 = *(const f32x4*)gn, g1 = *(const f32x4*)(gn + 4);
        const int j0 = 16 * (wc & 1) + 4 * fq; const bool rot = st != 0, second = (wc >> 1) != 0;
        f32x4 tpa[4], tpb[4];
#pragma unroll
        for (int q = 0; q < 4; ++q) { const int pos = second ? 16 * q + fr : (rot ? 4 * (st - 1) + 2 * (q & 1) + wr : 0);
            const f32x4 la = *(const f32x4*)(TA + (pos * 32 + j0) * 2), lb = *(const f32x4*)(TA + (pos * 32 + j0) * 2 + 4), id = (f32x4){1.f, 0.f, 1.f, 0.f};
            tpa[q] = rot ? la : id; tpb[q] = rot ? lb : id; }
#pragma unroll
        for (int ai = 0; ai < 2; ++ai)
#pragma unroll
            for (int m = 0; m < 4; ++m) { const int rt = ai * HALF + wr * 64 + m * 16 + fr; bf16_t* rowp = O + (size_t)(row0 + ai * HALF + m * 16) * 1536 + col0;
                const f32x4 ca = second ? tpa[m] : tpa[ai], cb = second ? tpb[m] : tpb[ai];
#pragma unroll
                for (int bj = 0; bj < 2; ++bj) { const f32x4 p4 = *(const PG8_LAS f32x4*)(xl + (rt * 2 + bj) * 4);
                    const float rinv = __builtin_amdgcn_rsqf(((p4[0] + p4[1]) + (p4[2] + p4[3])) * (1.0f / 128.0f) + 1e-6f);
                    const f32x4 a0 = acc[ai][bj][m][0] * rinv * g0, a1 = acc[ai][bj][m][1] * rinv * g1; f32x4 v0, v1;
                    v0[0] = a0[0] * ca[0] - a0[1] * ca[1]; v0[1] = a0[1] * ca[0] + a0[0] * ca[1]; v0[2] = a0[2] * ca[2] - a0[3] * ca[3]; v0[3] = a0[3] * ca[2] + a0[2] * ca[3];
                    v1[0] = a1[0] * cb[0] - a1[1] * cb[1]; v1[1] = a1[1] * cb[0] + a1[0] * cb[1]; v1[2] = a1[2] * cb[2] - a1[3] * cb[3]; v1[3] = a1[3] * cb[2] + a1[2] * cb[3];
                    u32x4 w; w.x = cvt_pk_bf16(v0[0], v0[1]); w.y = cvt_pk_bf16(v0[2], v0[3]); w.z = cvt_pk_bf16(v1[0], v1[1]); w.w = cvt_pk_bf16(v1[2], v1[3]);
                    *(u32x4*)(rowp + bj * HALF) = w; } }
        asm volatile("s_waitcnt lgkmcnt(0)" ::: "memory"); __builtin_amdgcn_s_barrier(); asm volatile("" ::: "memory");
    }
};
template <class Epi, class Sched, bool ALIGN_EPI = false, bool SP2 = false, bool GATHER = false>
__device__ __forceinline__ void gemm_phase(PG8_LAS unsigned char* lds, const Gemm g, const Sched& S, const Epi& E) {
    const int tid = threadIdx.x, wid = __builtin_amdgcn_readfirstlane(tid >> 6), lane = tid & 63, wr = wid >> 2, wc = wid & 3, fr = lane & 15, fq = lane >> 4;
    const int K = g.K, nt = K / BK;
    unsigned voffA[2], voffB[2];
#pragma unroll
    for (int i = 0; i < 2; ++i) { int R, C; stage_rc(tid * 16 + i * 8192, R, C); const int Rb = Epi::PERM ? ((R & ~31) + perm32(R & 31)) : R;
        voffA[i] = (unsigned)(R * K + C) * 2u; voffB[i] = (unsigned)(Rb * K + C) * 2u; }
    const size_t kstep = (size_t)(BK * 2);
    const size_t hstep = (size_t)HALF * K * 2;
    const size_t tstep = 2 * hstep;
    static_assert(!GATHER || SP2, "the gathered A operand is wired into the SP2 loop only");
    const size_t hstepA = GATHER ? (size_t)0 : hstep, tstepA = GATHER ? (size_t)0 : tstep;
    unsigned vc0[2], vc1[2], vn0[2], vn1[2];
#define PG8_VLOAD(u_, d0_, d1_) do { _Pragma("unroll") for (int _i = 0; _i < 2; ++_i) { if constexpr (GATHER) { int R_, C_; stage_rc(tid * 16 + _i * 8192, R_, C_); \
        d0_[_i] = (unsigned)g.rowidx[(u_).pm * BM + R_] * (unsigned)(K * 2) + (unsigned)(C_ * 2); d1_[_i] = (unsigned)g.rowidx[(u_).pm * BM + HALF + R_] * (unsigned)(K * 2) + (unsigned)(C_ * 2); } \
        else { d0_[_i] = voffA[_i]; d1_[_i] = voffA[_i]; } } } while (0)
    const unsigned ldsw = (unsigned)wid * 1024u;
    const int aoff = lds_byte(wr * 64 + fr, fq * 8), boff = lds_byte(wc * 32 + fr, fq * 8);
#define PG8_SA(b, h) (((b) * 2 + (h)) * HTB)
#define PG8_SB(b, h) ((4 + (b) * 2 + (h)) * HTB)
#define PG8_STAGE(bufoff, gbase, voff) do { _Pragma("unroll") for (int _i = 0; _i < 2; ++_i) \
        __builtin_amdgcn_global_load_lds((const unsigned*)((const char*)(gbase) + (voff)[_i]), (PG8_LAS unsigned*)(lds + (bufoff) + ldsw + _i * 8192), 16, 0, 0); } while (0)
#define PG8_LDA(dst, b, h) do { _Pragma("unroll") for (int m = 0; m < 4; ++m) _Pragma("unroll") for (int k = 0; k < 2; ++k) dst[m][k] = *(const PG8_LAS bf16x8*)(lds + PG8_SA(b, h) + aoff + m * 2048 + k * 1024); } while (0)
#define PG8_LDB(dst, b, h) do { _Pragma("unroll") for (int n = 0; n < 2; ++n) _Pragma("unroll") for (int k = 0; k < 2; ++k) dst[n][k] = *(const PG8_LAS bf16x8*)(lds + PG8_SB(b, h) + boff + n * 2048 + k * 1024); } while (0)
#define PG8_MMA(ai, bj, At, Bt) do { __builtin_amdgcn_s_setprio(1); _Pragma("unroll") for (int m = 0; m < 4; ++m) _Pragma("unroll") for (int n = 0; n < 2; ++n) _Pragma("unroll") for (int k = 0; k < 2; ++k) \
        acc[ai][bj][m][n] = __builtin_amdgcn_mfma_f32_16x16x32_bf16(Bt[n][k], At[m][k], acc[ai][bj][m][n], 0, 0, 0); __builtin_amdgcn_s_setprio(0); } while (0)
#define PG8_WAIT_V(n) asm volatile("s_waitcnt vmcnt(" #n ")" ::: "memory")
#define PG8_WAIT_L(n) asm volatile("s_waitcnt lgkmcnt(" #n ")" ::: "memory")
#define PG8_BAR __builtin_amdgcn_s_barrier()
#define PG8_SCHED __builtin_amdgcn_sched_barrier(0)
    Unit cur, nxt; int ui = 0;
    if (!S.next(0, cur)) return;
    f32x4 acc[2][2][4][2];
#pragma unroll
    for (int a = 0; a < 2; ++a)
#pragma unroll
        for (int b = 0; b < 2; ++b)
#pragma unroll
            for (int m = 0; m < 4; ++m)
#pragma unroll
                for (int n = 0; n < 2; ++n) acc[a][b][m][n] = (f32x4){0.f, 0.f, 0.f, 0.f};
    bf16x8 At[4][2], B0[2][2], B1[2][2];
    PG8_VLOAD(cur, vc0, vc1);
    const char* cA = (const char*)g.A + (size_t)cur.pm * tstepA; const char* cB = (const char*)g.Bt + (size_t)cur.pn * tstep;
    S.a_ready(cur);
    if constexpr (SP2) {
        PG8_STAGE(PG8_SB(0, 0), cB, voffB); PG8_STAGE(PG8_SB(0, 1), cB + hstep, voffB); PG8_STAGE(PG8_SA(0, 0), cA, vc0); PG8_STAGE(PG8_SA(0, 1), cA + hstepA, vc1);
        if (wr == 1) PG8_BAR;
        PG8_WAIT_V(2); PG8_BAR;
        PG8_STAGE(PG8_SB(1, 0), cB + kstep, voffB); PG8_STAGE(PG8_SA(1, 0), cA + kstep, vc0); PG8_STAGE(PG8_SB(1, 1), cB + hstep + kstep, voffB);
        PG8_WAIT_V(6); PG8_BAR;
    } else {
        PG8_STAGE(PG8_SB(0, 0), cB, voffB); PG8_STAGE(PG8_SA(0, 0), cA, voffA); PG8_STAGE(PG8_SB(0, 1), cB + hstep, voffB); PG8_STAGE(PG8_SA(0, 1), cA + hstep, voffA);
        if (wr == 1) PG8_BAR;
        PG8_WAIT_V(4); PG8_BAR;
        PG8_STAGE(PG8_SB(1, 0), cB + kstep, voffB); PG8_STAGE(PG8_SA(1, 0), cA + kstep, voffA); PG8_STAGE(PG8_SB(1, 1), cB + hstep + kstep, voffB);
        PG8_WAIT_V(6); PG8_BAR;
    }
    for (;;) {
        const bool has_next = S.next(ui + 1, nxt);
        if (has_next) PG8_VLOAD(nxt, vn0, vn1); else { vn0[0] = vc0[0]; vn0[1] = vc0[1]; vn1[0] = vc1[0]; vn1[1] = vc1[1]; }
        const char* nA = has_next ? (const char*)g.A + (size_t)nxt.pm * tstepA : cA; const char* nB = has_next ? (const char*)g.Bt + (size_t)nxt.pn * tstep : cB;
        for (int t = 0; t < nt; t += 2) {
            const bool last = (t == nt - 2);
            const char* a1 = cA + (size_t)(t + 1) * kstep;
            const char* a2 = last ? nA : cA + (size_t)(t + 2) * kstep; const char* b2 = last ? nB : cB + (size_t)(t + 2) * kstep;
            const char* a3 = a2 + kstep; const char* b3 = b2 + kstep;
            if (last && has_next) S.a_ready(nxt);
            unsigned s0[2], s1[2]; s0[0] = last ? vn0[0] : vc0[0]; s0[1] = last ? vn0[1] : vc0[1]; s1[0] = last ? vn1[0] : vc1[0]; s1[1] = last ? vn1[1] : vc1[1];
            if constexpr (SP2) {
            PG8_LDB(B0, 0, 0); PG8_LDB(B1, 0, 1); PG8_SCHED; PG8_LDA(At, 0, 0); PG8_STAGE(PG8_SA(1, 1), a1 + hstepA, vc1);
            PG8_WAIT_V(8); PG8_WAIT_L(0); PG8_BAR; PG8_MMA(0, 0, At, B0); PG8_MMA(0, 1, At, B1); PG8_BAR; PG8_SCHED;
            PG8_LDA(At, 0, 1); PG8_STAGE(PG8_SB(0, 0), b2, voffB); PG8_STAGE(PG8_SB(0, 1), b2 + hstep, voffB); PG8_STAGE(PG8_SA(0, 0), a2, s0);
            PG8_WAIT_V(8); PG8_WAIT_L(0); PG8_BAR; PG8_MMA(1, 0, At, B0); PG8_MMA(1, 1, At, B1); PG8_BAR; PG8_SCHED;
            PG8_LDB(B0, 1, 0); PG8_LDB(B1, 1, 1); PG8_SCHED; PG8_LDA(At, 1, 0); PG8_STAGE(PG8_SA(0, 1), a2 + hstepA, s1);
            PG8_WAIT_V(8); PG8_WAIT_L(0); PG8_BAR; PG8_MMA(0, 0, At, B0); PG8_MMA(0, 1, At, B1); PG8_BAR; PG8_SCHED;
            PG8_LDA(At, 1, 1); PG8_STAGE(PG8_SB(1, 0), b3, voffB); PG8_STAGE(PG8_SB(1, 1), b3 + hstep, voffB); PG8_STAGE(PG8_SA(1, 0), a3, s0);
            PG8_WAIT_V(8); PG8_WAIT_L(0); PG8_BAR; PG8_MMA(1, 0, At, B0); PG8_MMA(1, 1, At, B1); PG8_BAR; PG8_SCHED;
            } else {
            PG8_LDB(B0, 0, 0); PG8_SCHED; PG8_LDA(At, 0, 0); PG8_STAGE(PG8_SA(1, 1), a1 + hstep, voffA);
            PG8_WAIT_L(8); PG8_BAR; PG8_WAIT_L(0); PG8_MMA(0, 0, At, B0); PG8_BAR; PG8_SCHED;
            PG8_LDB(B1, 0, 1); PG8_STAGE(PG8_SB(0, 0), b2, voffB);
            PG8_BAR; PG8_WAIT_L(0); PG8_MMA(0, 1, At, B1); PG8_BAR;
            PG8_LDA(At, 0, 1); PG8_STAGE(PG8_SA(0, 0), a2, voffA);
            PG8_BAR; PG8_WAIT_L(0); PG8_MMA(1, 0, At, B0); PG8_BAR; PG8_SCHED;
            PG8_STAGE(PG8_SB(0, 1), b2 + hstep, voffB);
            PG8_WAIT_V(6); PG8_BAR; PG8_MMA(1, 1, At, B1); PG8_BAR;
            PG8_LDB(B0, 1, 0); PG8_SCHED; PG8_LDA(At, 1, 0); PG8_STAGE(PG8_SA(0, 1), a2 + hstep, voffA);
            PG8_WAIT_L(8); PG8_BAR; PG8_WAIT_L(0); PG8_MMA(0, 0, At, B0); PG8_BAR; PG8_SCHED;
            PG8_LDB(B1, 1, 1); PG8_STAGE(PG8_SB(1, 0), b3, voffB);
            PG8_BAR; PG8_WAIT_L(0); PG8_MMA(0, 1, At, B1); PG8_BAR;
            PG8_LDA(At, 1, 1); PG8_STAGE(PG8_SA(1, 0), a3, voffA);
            PG8_BAR; PG8_WAIT_L(0); PG8_MMA(1, 0, At, B0); PG8_BAR; PG8_SCHED;
            PG8_STAGE(PG8_SB(1, 1), b3 + hstep, voffB);
            PG8_WAIT_V(6); PG8_BAR; PG8_MMA(1, 1, At, B1); PG8_BAR;
            }
        }
        if constexpr (ALIGN_EPI) { if (wr == 0) PG8_BAR; }
        if constexpr (!Epi::AFTER_DRAIN) { E(acc, cur, wr, wc, fr, fq); S.done(cur); }
        if (!has_next) break;
#pragma unroll
        for (int a = 0; a < 2; ++a)
#pragma unroll
            for (int b = 0; b < 2; ++b)
#pragma unroll
                for (int m = 0; m < 4; ++m)
#pragma unroll
                    for (int n = 0; n < 2; ++n) acc[a][b][m][n] = (f32x4){0.f, 0.f, 0.f, 0.f};
        cur = nxt; cA = nA; cB = nB; ++ui; vc0[0] = vn0[0]; vc0[1] = vn0[1]; vc1[0] = vn1[0]; vc1[1] = vn1[1];
        if constexpr (ALIGN_EPI) { if (wr == 1) PG8_BAR; }
    }
    PG8_WAIT_V(0);
    if constexpr (!ALIGN_EPI) { if (wr == 0) PG8_BAR; }
    PG8_BAR;
    if constexpr (Epi::AFTER_DRAIN) { E.fused(acc, cur, wr, wc, fr, fq, lds, wid, lane); S.done(cur); }
#undef PG8_VLOAD
#undef PG8_SA
#undef PG8_SB
#undef PG8_STAGE
#undef PG8_LDA
#undef PG8_LDB
#undef PG8_MMA
#undef PG8_WAIT_V
#undef PG8_WAIT_L
#undef PG8_BAR
#undef PG8_SCHED
}
}
namespace att {
using bf16 = unsigned short;
constexpr int   D = 128, NW = 8, QBLK = 32, KVBLK = 64;
constexpr float SCALE = 0.088388347648318440f;
constexpr float THR = 8.f;
constexpr int SDEPTH = 2;
constexpr int LDQ = 1536, LDK = 1536, LDO = 1024;
constexpr size_t SHM_V = KVBLK * D * 2, SHM_K = KVBLK * D * 2, SHM_ATTN = 2 * SHM_V + 2 * SHM_K + NW * 64 * 4;
__device__ __forceinline__ unsigned short f2bf16(float f) { unsigned u = __builtin_bit_cast(unsigned, f); return (unsigned short)((u + 0x7fffu + ((u >> 16) & 1u)) >> 16); }
using bf16x8 = __attribute__((ext_vector_type(8))) short;
using s16x4  = __attribute__((ext_vector_type(4))) short;
using f32x16 = __attribute__((ext_vector_type(16))) float;
using f32x8  = __attribute__((ext_vector_type(8))) float;
using u32x4  = __attribute__((ext_vector_type(4))) unsigned;
#define KSWZ(row, colB) ((row) * 256 + ((colB) ^ (((row) & 7) << 4)))
#define SBAR() __builtin_amdgcn_sched_barrier(0)
__device__ __forceinline__ int crow(int r, int hi) { return (r & 3) + 8 * (r >> 2) + 4 * hi; }
__device__ __forceinline__ unsigned cvtpk(float lo, float hi) {
  unsigned r; asm volatile("v_cvt_pk_bf16_f32 %0, %1, %2" : "=v"(r) : "v"(lo), "v"(hi)); return r;
}
template <typename TIn> struct Stage;
template <> struct Stage<bf16>  { using T = bf16x8;
  __device__ static __forceinline__ T ld8(const bf16* p) { return *reinterpret_cast<const bf16x8*>(p); }
  __device__ static __forceinline__ bf16x8 tobf(T x) { return x; } };
template <> struct Stage<float> { using T = f32x8;
  __device__ static __forceinline__ T ld8(const float* p) { return *reinterpret_cast<const f32x8*>(p); }
  __device__ static __forceinline__ bf16x8 tobf(T x) {
    u32x4 w = {cvtpk(x[0], x[1]), cvtpk(x[2], x[3]), cvtpk(x[4], x[5]), cvtpk(x[6], x[7])}; return *reinterpret_cast<bf16x8*>(&w); } };

__device__ __forceinline__ void partialSM(f32x16& p0, f32x16& p1, float& m_reg, float& mn, float& alpha) {
  constexpr float C = SCALE * 1.4426950408889634f;
  float pmax = p0[0]; for (int r = 1; r < 16; ++r) pmax = fmaxf(pmax, p0[r]); for (int r = 0; r < 16; ++r) pmax = fmaxf(pmax, p1[r]);
  { auto rr = __builtin_amdgcn_permlane32_swap(__float_as_uint(pmax), __float_as_uint(pmax), false, false);
    pmax = fmaxf(__uint_as_float(rr[0]), __uint_as_float(rr[1])); }
  if (__builtin_expect(__all(pmax - m_reg <= THR / SCALE), 1)) { mn = m_reg; alpha = 1.f; }
  else { mn = fmaxf(m_reg, pmax); alpha = __builtin_amdgcn_exp2f((m_reg - mn) * C); m_reg = mn; }
  float mnC = -mn * C;
  for (int r = 0; r < 16; ++r) p0[r] = fmaf(p0[r], C, mnC); for (int r = 0; r < 16; ++r) p1[r] = fmaf(p1[r], C, mnC);
  for (int r = 0; r < 16; ++r) p0[r] = __builtin_amdgcn_exp2f(p0[r]);
}
__device__ __forceinline__ void finishSM(f32x16& p0, f32x16& p1, float alpha, float& l_reg, bf16x8& pa0, bf16x8& pa1, bf16x8& pa2, bf16x8& pa3) {
  for (int r = 0; r < 16; ++r) p1[r] = __builtin_amdgcn_exp2f(p1[r]);
  float ps = 0; for (int r = 0; r < 16; ++r) ps += p0[r]; for (int r = 0; r < 16; ++r) ps += p1[r];
  { auto rr = __builtin_amdgcn_permlane32_swap(__float_as_uint(ps), __float_as_uint(ps), false, false);
    ps = __uint_as_float(rr[0]) + __uint_as_float(rr[1]); }
  l_reg = l_reg * alpha + ps;
#define PK4(P, BASE, OUT) do { unsigned a0 = cvtpk(P[BASE + 0], P[BASE + 1]), a1 = cvtpk(P[BASE + 2], P[BASE + 3]);   \
    unsigned b0 = cvtpk(P[BASE + 4], P[BASE + 5]), b1 = cvtpk(P[BASE + 6], P[BASE + 7]);                              \
    auto r0 = __builtin_amdgcn_permlane32_swap(a0, b0, false, false); auto r1 = __builtin_amdgcn_permlane32_swap(a1, b1, false, false); \
    u32x4 w = {r0[0], r1[0], r0[1], r1[1]}; OUT = *reinterpret_cast<bf16x8*>(&w); } while (0)
  PK4(p0, 0, pa0); PK4(p0, 8, pa1); PK4(p1, 0, pa2); PK4(p1, 8, pa3);
#undef PK4
}
__device__ __forceinline__ void qkt(f32x16& p0, f32x16& p1, const bf16* Ks, const bf16x8* qr, int r32, int hi) {
  p0 = f32x16{}; p1 = f32x16{};
  for (int d0 = 0; d0 < 8; ++d0) { int cb = (d0 * 16 + hi * 8) * 2;
    bf16x8 b0 = *reinterpret_cast<const bf16x8*>((const char*)Ks + KSWZ(r32, cb));
    bf16x8 b1 = *reinterpret_cast<const bf16x8*>((const char*)Ks + KSWZ(32 + r32, cb));
    p0 = __builtin_amdgcn_mfma_f32_32x32x16_bf16(b0, qr[d0], p0, 0, 0, 0);
    p1 = __builtin_amdgcn_mfma_f32_32x32x16_bf16(b1, qr[d0], p1, 0, 0, 0); }
}
__device__ __forceinline__ int v_st(int k, int c) { const int kk = (k & ~0xC) | ((k & 4) << 1) | ((k & 8) >> 1); return ((kk >> 3) * 4 + (c >> 5)) * 512 + ((kk & 7) * 32 + (c & 31)) * 2; }
__device__ __forceinline__ int v_rd_base(int lane) { return ((lane & 3) << 3) | (((lane >> 2) & 3) << 6) | (((lane >> 4) & 1) << 5) | (((lane >> 5) & 1) << 8); }
constexpr int v_rd_off(int d0, int ks, int half) { return d0 * 512 + ks * 4096 + half * 2048; }
template <int OFF> __device__ __forceinline__ s16x4 tr_read(int vb) {
  s16x4 r; asm volatile("ds_read_b64_tr_b16 %0, %1 offset:%2" : "=&v"(r) : "v"(vb), "i"(OFF) : "memory"); return r;
}
template <int D0> __device__ __forceinline__ void pv_one(f32x16& od, int vb, bf16x8 pa0, bf16x8 pa1, bf16x8 pa2, bf16x8 pa3) {
  const s16x4 l0 = tr_read<v_rd_off(D0, 0, 0)>(vb), h0 = tr_read<v_rd_off(D0, 0, 1)>(vb), l1 = tr_read<v_rd_off(D0, 1, 0)>(vb), h1 = tr_read<v_rd_off(D0, 1, 1)>(vb);
  const s16x4 l2 = tr_read<v_rd_off(D0, 2, 0)>(vb), h2 = tr_read<v_rd_off(D0, 2, 1)>(vb), l3 = tr_read<v_rd_off(D0, 3, 0)>(vb), h3 = tr_read<v_rd_off(D0, 3, 1)>(vb);
  asm volatile("s_waitcnt lgkmcnt(0)" ::: "memory"); SBAR();
#define PK(L, H) (bf16x8){L[0], L[1], L[2], L[3], H[0], H[1], H[2], H[3]}
  od = __builtin_amdgcn_mfma_f32_32x32x16_bf16(pa0, PK(l0, h0), od, 0, 0, 0);
  od = __builtin_amdgcn_mfma_f32_32x32x16_bf16(pa1, PK(l1, h1), od, 0, 0, 0);
  od = __builtin_amdgcn_mfma_f32_32x32x16_bf16(pa2, PK(l2, h2), od, 0, 0, 0);
  od = __builtin_amdgcn_mfma_f32_32x32x16_bf16(pa3, PK(l3, h3), od, 0, 0, 0);
#undef PK
}
__device__ __forceinline__ void pv_d0(f32x16* o, int vb, bf16x8 pa0, bf16x8 pa1, bf16x8 pa2, bf16x8 pa3) {
  pv_one<0>(o[0], vb, pa0, pa1, pa2, pa3); pv_one<1>(o[1], vb, pa0, pa1, pa2, pa3); pv_one<2>(o[2], vb, pa0, pa1, pa2, pa3); pv_one<3>(o[3], vb, pa0, pa1, pa2, pa3);
}

template <typename TQ, int LDQ_ = LDQ, int LDK_ = LDK>
__device__ __forceinline__ void attn_dense_body(const TQ* __restrict__ Qb, const bf16* __restrict__ Kh, const bf16* __restrict__ Vh,
                                                bf16* __restrict__ Ob, int seq, char* lds) {
  using St = Stage<bf16>; using SQ = Stage<TQ>;
  const int tid = threadIdx.x, wid = tid >> 6, lane = tid & 63, r32 = lane & 31, hi = lane >> 5;
  bf16* V_lds = (bf16*)lds; bf16* K_lds = (bf16*)(lds + 2 * SHM_V);
  float* ws = (float*)(lds + 2 * SHM_V + 2 * SHM_K) + wid * 64; float* li_l = ws; float* al_l = ws + 32;
  float m_reg = -1e30f, l_reg = 0; f32x16 o[4] = {}; bf16x8 qr[8];
  const TQ* Qw = Qb + (long)(wid * QBLK + r32) * LDQ_ + hi * 8;
#pragma unroll
  for (int d0 = 0; d0 < 8; ++d0) qr[d0] = SQ::tobf(SQ::ld8(Qw + d0 * 16));
  const int sr = tid >> 4, sc = (tid & 15) * 8, vst0 = v_st(sr, sc), vst1 = v_st(32 + sr, sc);
  const int vb0 = (int)(uintptr_t)V_lds + v_rd_base(lane);
  struct { typename St::T vs0, vs1, ks0, ks1; } sr_[SDEPTH];
#define SLOAD(i, k0) do { sr_[i].vs0 = St::ld8(&Vh[(long)((k0) + sr) * LDK_ + sc]); sr_[i].vs1 = St::ld8(&Vh[(long)((k0) + 32 + sr) * LDK_ + sc]); \
    sr_[i].ks0 = St::ld8(&Kh[(long)((k0) + sr) * LDK_ + sc]); sr_[i].ks1 = St::ld8(&Kh[(long)((k0) + 32 + sr) * LDK_ + sc]); } while (0)
#define SWRITE(b, i) do { *(bf16x8*)((char*)V_lds + (b) * SHM_V + vst0) = St::tobf(sr_[i].vs0);          \
    *(bf16x8*)((char*)V_lds + (b) * SHM_V + vst1) = St::tobf(sr_[i].vs1); int kc = sc * 2;               \
    *(bf16x8*)((char*)K_lds + (b) * SHM_K + KSWZ(sr, kc)) = St::tobf(sr_[i].ks0);                       \
    *(bf16x8*)((char*)K_lds + (b) * SHM_K + KSWZ(32 + sr, kc)) = St::tobf(sr_[i].ks1); } while (0)
#define SWAIT() do { if constexpr (SDEPTH == 2) asm volatile("s_waitcnt vmcnt(4)" ::: "memory"); else asm volatile("s_waitcnt vmcnt(0)" ::: "memory"); } while (0)
#define RESC(a) do { if (__any((a) < 1.f)) { if (hi == 0) al_l[r32] = (a); asm volatile("s_waitcnt lgkmcnt(0)" ::: "memory"); \
    for (int d = 0; d < 4; ++d) for (int r = 0; r < 16; ++r) o[d][r] *= al_l[crow(r, hi)]; } } while (0)
  f32x16 pA0, pA1, pB0, pB1; float mnA, mnB, alA, alB; bf16x8 pa0, pa1, pa2, pa3; const int NT = seq / KVBLK;
  constexpr int SE = 0, SO = SDEPTH - 1;
  SLOAD(SE, 0); asm volatile("s_waitcnt vmcnt(0)" ::: "memory"); SWRITE(0, SE); __syncthreads();
  qkt(pA0, pA1, K_lds, qr, r32, hi); partialSM(pA0, pA1, m_reg, mnA, alA);
  SLOAD(SO, KVBLK); if constexpr (SDEPTH == 2) { if (2 < NT) SLOAD(SE, 2 * KVBLK); }
  SWAIT(); SWRITE(1, SO); __syncthreads();
  for (int j = 1; j + 1 < NT; j += 2) {
    SBAR(); qkt(pB0, pB1, (bf16*)((char*)K_lds + SHM_K), qr, r32, hi);
    finishSM(pA0, pA1, alA, l_reg, pa0, pa1, pa2, pa3); SBAR();
    SLOAD(SO, (j + SDEPTH) * KVBLK); SBAR();
    pv_d0(o, vb0, pa0, pa1, pa2, pa3); partialSM(pB0, pB1, m_reg, mnB, alB);
    __syncthreads(); SWAIT(); SWRITE(0, SE);
    RESC(alB); __syncthreads();
    SBAR(); qkt(pA0, pA1, K_lds, qr, r32, hi);
    finishSM(pB0, pB1, alB, l_reg, pa0, pa1, pa2, pa3); SBAR();
    if (SDEPTH == 1 || j + 3 < NT) SLOAD(SE, (j + 1 + SDEPTH) * KVBLK); SBAR();
    pv_d0(o, vb0 + (int)SHM_V, pa0, pa1, pa2, pa3); partialSM(pA0, pA1, m_reg, mnA, alA);
    __syncthreads(); SWAIT(); SWRITE(1, SO);
    RESC(alA); __syncthreads();
  }
  SBAR(); qkt(pB0, pB1, (bf16*)((char*)K_lds + SHM_K), qr, r32, hi);
  finishSM(pA0, pA1, alA, l_reg, pa0, pa1, pa2, pa3); SBAR();
  pv_d0(o, vb0, pa0, pa1, pa2, pa3); partialSM(pB0, pB1, m_reg, mnB, alB);
  __syncthreads(); RESC(alB);
  finishSM(pB0, pB1, alB, l_reg, pa0, pa1, pa2, pa3); SBAR();
  pv_d0(o, vb0 + (int)SHM_V, pa0, pa1, pa2, pa3);
  if (hi == 0) li_l[r32] = l_reg; asm volatile("s_waitcnt lgkmcnt(0)" ::: "memory");
  bf16* Ow = Ob + (long)(wid * QBLK) * LDO;
  { const bool odd = (r32 & 1) != 0; const int cpair = r32 & ~1;
#pragma unroll
    for (int r = 0; r < 16; r += 2) { bf16* rowp = Ow + (long)crow(odd ? r + 1 : r, hi) * LDO + cpair; const float ra = __builtin_amdgcn_rcpf(li_l[crow(r, hi)]), rb = __builtin_amdgcn_rcpf(li_l[crow(r + 1, hi)]);
#pragma unroll
      for (int d0 = 0; d0 < 4; ++d0) { const unsigned a = f2bf16(o[d0][r] * ra), b = f2bf16(o[d0][r + 1] * rb);
        const unsigned recv = (unsigned)__builtin_amdgcn_update_dpp(0, (int)(odd ? a : b), 0xB1, 0xF, 0xF, true);
        *(unsigned*)(rowp + d0 * 32) = odd ? (recv | (b << 16)) : (a | (recv << 16)); } } }
#undef SLOAD
#undef SWRITE
#undef SWAIT
#undef RESC
}

__device__ __forceinline__ void q_norm_rope_inplace(bf16* Qb, int t0, const float* __restrict__ qgain, const float* __restrict__ TA) {
  const int tid = threadIdx.x, wid = tid >> 6, lane = tid & 63, r32 = lane & 31, hi = lane >> 5;
  const bf16* Qw = Qb + (long)(wid * QBLK + r32) * LDQ + hi * 8;
  bf16x8 qr[8];
#pragma unroll
  for (int d0 = 0; d0 < 8; ++d0) qr[d0] = *reinterpret_cast<const bf16x8*>(Qw + d0 * 16);
  {
    float qf[8][8]; float ss = 0.f;
#pragma unroll
    for (int d0 = 0; d0 < 8; ++d0) { const u32x4 w = *reinterpret_cast<const u32x4*>(&qr[d0]);
      qf[d0][0] = __uint_as_float(w.x << 16); qf[d0][1] = __uint_as_float(w.x & 0xffff0000u); qf[d0][2] = __uint_as_float(w.y << 16); qf[d0][3] = __uint_as_float(w.y & 0xffff0000u);
      qf[d0][4] = __uint_as_float(w.z << 16); qf[d0][5] = __uint_as_float(w.z & 0xffff0000u); qf[d0][6] = __uint_as_float(w.w << 16); qf[d0][7] = __uint_as_float(w.w & 0xffff0000u);
#pragma unroll
      for (int i = 0; i < 8; ++i) ss += qf[d0][i] * qf[d0][i]; }
    { auto rr = __builtin_amdgcn_permlane32_swap(__float_as_uint(ss), __float_as_uint(ss), false, false); ss = __uint_as_float(rr[0]) + __uint_as_float(rr[1]); }
    const float rinv = 1.0f / sqrtf(ss * (1.0f / 128.0f) + 1e-6f);
#pragma unroll
    for (int d0 = 0; d0 < 8; ++d0) { const f32x8 g = *reinterpret_cast<const f32x8*>(qgain + 16 * d0 + 8 * hi);
#pragma unroll
      for (int i = 0; i < 8; ++i) qf[d0][i] = qf[d0][i] * rinv * g[i]; }
    const int t = t0 + wid * QBLK + r32;
#pragma unroll
    for (int ax = 0; ax < 2; ++ax) { const int pos = ax ? (t & 63) : (t >> 6);
#pragma unroll
      for (int dd = 0; dd < 2; ++dd) {
        const float* tp = TA + ((size_t)pos * 32 + 16 * dd + 8 * hi) * 2; const f32x8 c0 = *reinterpret_cast<const f32x8*>(tp), c1 = *reinterpret_cast<const f32x8*>(tp + 8);
        const float cs[8] = {c0[0], c0[2], c0[4], c0[6], c1[0], c1[2], c1[4], c1[6]}, sn[8] = {c0[1], c0[3], c0[5], c0[7], c1[1], c1[3], c1[5], c1[7]};
#pragma unroll
        for (int i = 0; i < 8; ++i) { const float xf = qf[4 * ax + dd][i], xs = qf[4 * ax + dd + 2][i]; qf[4 * ax + dd][i] = xf * cs[i] - xs * sn[i]; qf[4 * ax + dd + 2][i] = xs * cs[i] + xf * sn[i]; } } }
#pragma unroll
    for (int d0 = 0; d0 < 8; ++d0) { u32x4 w = {cvtpk(qf[d0][0], qf[d0][1]), cvtpk(qf[d0][2], qf[d0][3]), cvtpk(qf[d0][4], qf[d0][5]), cvtpk(qf[d0][6], qf[d0][7])}; qr[d0] = *reinterpret_cast<bf16x8*>(&w); }
  }
  bf16* qo = Qb + (long)(wid * QBLK + r32) * LDQ + hi * 8;
#pragma unroll
  for (int d0 = 0; d0 < 8; ++d0) *reinterpret_cast<bf16x8*>(qo + d0 * 16) = qr[d0];
  asm volatile("s_waitcnt vmcnt(0)" ::: "memory");
  __builtin_amdgcn_fence(__ATOMIC_ACQUIRE, "agent");
  asm volatile("s_waitcnt vmcnt(0)" ::: "memory");
}
#undef KSWZ
#undef SBAR
}
namespace ret {
#define RET_LAS __attribute__((address_space(3)))
typedef unsigned short bf16_t;
typedef short bf16x8 __attribute__((ext_vector_type(8)));
typedef short s16x4 __attribute__((ext_vector_type(4)));
typedef float f32x4 __attribute__((ext_vector_type(4)));
typedef float f32x16 __attribute__((ext_vector_type(16)));
typedef float f32x2 __attribute__((ext_vector_type(2)));
typedef unsigned u32x4 __attribute__((ext_vector_type(4)));
typedef unsigned u32x2 __attribute__((ext_vector_type(2)));
constexpr int T = 32, NS = 72;
constexpr int QS = 520, KS = 544, VS = 288, PS = 80, YS = 528;
constexpr int Q_OFF = 0, K_OFF = T * QS, V_OFF = K_OFF + T * KS, VZ_OFF = V_OFF + T * VS, STG = VZ_OFF + T * VS;
constexpr int P_OFF = 2 * STG, YT_OFF = P_OFF + T * PS, YT_BYTES = T * YS, LDS_END = YT_OFF + 2 * YT_BYTES;
constexpr int LDQKV = 4096, LDY = 2048, SLR = 2304;
static_assert(STG % 16 == 0 && P_OFF % 16 == 0 && YT_OFF % 16 == 0 && K_OFF % 16 == 0 && V_OFF % 16 == 0 && VZ_OFF % 16 == 0, "LDS alignment");

__device__ __forceinline__ unsigned f2bf(float f) { unsigned u = __builtin_bit_cast(unsigned, f); return (u + 0x7fffu + ((u >> 16) & 1u)) >> 16; }
__device__ __forceinline__ unsigned pk2(float lo, float hi) { unsigned r; asm volatile("v_cvt_pk_bf16_f32 %0, %1, %2" : "=v"(r) : "v"(lo), "v"(hi)); return r; }
__device__ __forceinline__ float bflo(unsigned w) { return __builtin_bit_cast(float, w << 16); }
__device__ __forceinline__ float bfhi(unsigned w) { return __builtin_bit_cast(float, w & 0xffff0000u); }
template <int CTRL> __device__ __forceinline__ float dpp_f(float v) { return __builtin_bit_cast(float, __builtin_amdgcn_update_dpp(0, __builtin_bit_cast(int, v), CTRL, 0xF, 0xF, true)); }
template <int OFF> __device__ __forceinline__ s16x4 trr(unsigned base) { s16x4 r; asm volatile("ds_read_b64_tr_b16 %0, %1 offset:%2" : "=&v"(r) : "v"(base), "i"(OFF) : "memory"); return r; }
#define RET_LWAIT() do { asm volatile("s_waitcnt lgkmcnt(0)" ::: "memory"); __builtin_amdgcn_sched_barrier(0); } while (0)
#define RET_PK(L, H) (bf16x8){L[0], L[1], L[2], L[3], H[0], H[1], H[2], H[3]}
#define RET_MFMA16(a, b, c) __builtin_amdgcn_mfma_f32_16x16x32_bf16((a), (b), (c), 0, 0, 0)
#define RET_MFMA32(a, b, c) __builtin_amdgcn_mfma_f32_32x32x16_bf16((a), (b), (c), 0, 0, 0)
#define RET_BAR() asm volatile("s_waitcnt lgkmcnt(0)\n\ts_barrier" ::: "memory")
#define RET_SIDX(it_) (sweep ? (it_) : ((it_) < 8 ? 7 - (it_) : 79 - (it_)))

template <int VAR = 0> __device__ __forceinline__ void ret_item(RET_LAS unsigned char* lds, const bf16_t* __restrict__ qkv, bf16_t* __restrict__ Y, float* __restrict__ PSt, int bl, int h, int eq, float lgf, float lgb) {
    const int tid = threadIdx.x, w = __builtin_amdgcn_readfirstlane(tid >> 6), lane = tid & 63;
    const size_t rowbase = (size_t)bl * SLR;
    const unsigned ldsb = (unsigned)(uintptr_t)lds;

    for (int sweep = 0; sweep < 2; ++sweep) {
        const float lg2 = (sweep ? lgf : lgb) * 1.4426950408889634f;
        if (w < 4) {
            int lz = lane; asm volatile("" : "+v"(lz));
            const int cw = w, l32 = lz & 31, hh = lz >> 5, l16 = lz & 15, g16 = lz >> 4, q4 = l16 >> 2, p4 = l16 & 3;
            const float gam = __builtin_amdgcn_exp2f(lg2 * (float)T);
            const float xi = __builtin_amdgcn_exp2f(lg2 * (float)(sweep ? l32 + 1 : T - l32));
            const int cqh = cw >> 1, cqc = cw & 1;
            float pf[4];
#pragma unroll
            for (int i = 0; i < 4; ++i) { const int c = 16 * cqc + l16, cp = 16 * cqh + 4 * g16 + i, diff = sweep ? (c - cp) : (cp - c); pf[i] = diff >= 0 ? __builtin_amdgcn_exp2f(lg2 * (float)diff) : 0.f; }
            f32x16 S[8];
#pragma unroll
            for (int i = 0; i < 8; ++i)
#pragma unroll
                for (int r = 0; r < 16; ++r) S[i][r] = 0.f;
            RET_BAR();
            for (int it = 0; it < NS; ++it) {
                RET_LAS unsigned char* st = lds + (it & 1) * STG;
                const unsigned stb = ldsb + (it & 1) * STG;
                if (!(VAR & 4)) {
                    f32x4 pacc = (f32x4){0.f, 0.f, 0.f, 0.f};
#pragma unroll
                    for (int ks = 0; ks < 8; ++ks) {
                        const bf16x8 ak = *(const RET_LAS bf16x8*)(st + K_OFF + (16 * cqh + l16) * KS + (32 * ks + 8 * g16) * 2);
                        const u32x2 q0 = *(const RET_LAS u32x2*)(st + Q_OFF + (16 * cqc + l16) * QS + (32 * ks + 8 * g16) * 2), q1 = *(const RET_LAS u32x2*)(st + Q_OFF + (16 * cqc + l16) * QS + (32 * ks + 8 * g16) * 2 + 8);
                        u32x4 qq; qq.x = q0.x; qq.y = q0.y; qq.z = q1.x; qq.w = q1.y;
                        pacc = RET_MFMA16(ak, __builtin_bit_cast(bf16x8, qq), pacc); }
                    u32x2 o; o.x = pk2(pacc[0] * pf[0], pacc[1] * pf[1]); o.y = pk2(pacc[2] * pf[2], pacc[3] * pf[3]);
                    *(RET_LAS u32x2*)(lds + P_OFF + (16 * cqc + l16) * PS + (16 * cqh + 4 * g16) * 2) = o;
                }
                RET_BAR();
                if (!(VAR & 2)) {
                    f32x16 pv;
#pragma unroll
                    for (int r = 0; r < 16; ++r) pv[r] = 0.f;
#pragma unroll
                    for (int dt = 0; dt < 8; ++dt)
#pragma unroll
                        for (int s = 0; s < 2; ++s) {
                            u32x4 sa; sa.x = pk2(S[dt][8 * s + 0], S[dt][8 * s + 1]); sa.y = pk2(S[dt][8 * s + 2], S[dt][8 * s + 3]); sa.z = pk2(S[dt][8 * s + 4], S[dt][8 * s + 5]); sa.w = pk2(S[dt][8 * s + 6], S[dt][8 * s + 7]);
                            const u32x2 lo = *(const RET_LAS u32x2*)(st + Q_OFF + l32 * QS + (32 * dt + 16 * s + 4 * hh) * 2), hi = *(const RET_LAS u32x2*)(st + Q_OFF + l32 * QS + (32 * dt + 16 * s + 8 + 4 * hh) * 2);
                            u32x4 qq; qq.x = lo.x; qq.y = lo.y; qq.z = hi.x; qq.w = hi.y;
                            pv = RET_MFMA32(__builtin_bit_cast(bf16x8, sa), __builtin_bit_cast(bf16x8, qq), pv); }
                    pv = pv * xi;
                    { const unsigned a0 = stb + V_OFF + (8 * hh + q4) * VS + (32 * cw + 16 * (g16 & 1) + 4 * p4) * 2;
                      const s16x4 l0 = trr<0>(a0), h0 = trr<4 * VS>(a0), l1 = trr<16 * VS>(a0), h1 = trr<20 * VS>(a0);
                      const bf16x8 bp0 = *(const RET_LAS bf16x8*)(lds + P_OFF + l32 * PS + (8 * hh) * 2), bp1 = *(const RET_LAS bf16x8*)(lds + P_OFF + l32 * PS + (16 + 8 * hh) * 2);
                      RET_LWAIT();
                      pv = RET_MFMA32(RET_PK(l0, h0), bp0, pv); pv = RET_MFMA32(RET_PK(l1, h1), bp1, pv); }
                    RET_LAS unsigned char* yt = lds + YT_OFF + (it & 1) * YT_BYTES + l32 * YS + (32 * cw + 4 * hh) * 4;
#pragma unroll
                    for (int q = 0; q < 4; ++q) *(RET_LAS f32x4*)(yt + q * 32) = (f32x4){pv[4 * q], pv[4 * q + 1], pv[4 * q + 2], pv[4 * q + 3]};
                }
                if (!(VAR & 16)) {
                    const unsigned z0 = stb + VZ_OFF + (8 * hh + q4) * VS + (32 * cw + 16 * (g16 & 1) + 4 * p4) * 2;
                    const s16x4 zl0 = trr<0>(z0), zh0 = trr<4 * VS>(z0), zl1 = trr<16 * VS>(z0), zh1 = trr<20 * VS>(z0);
                    const unsigned k0 = stb + K_OFF + (8 * hh + q4) * KS + (16 * (g16 & 1) + 4 * p4) * 2;
#define RET_RD(dt, a, b, c, d) a = trr<64 * (dt)>(k0); b = trr<64 * (dt) + 4 * KS>(k0); c = trr<64 * (dt) + 16 * KS>(k0); d = trr<64 * (dt) + 20 * KS>(k0)
#define RET_WAIT4() do { asm volatile("s_waitcnt lgkmcnt(4)" ::: "memory"); __builtin_amdgcn_sched_barrier(0); } while (0)
#define RET_UP(dt, a, b, c, d) do { S[dt] = S[dt] * gam; S[dt] = RET_MFMA32(RET_PK(a, b), bz0, S[dt]); S[dt] = RET_MFMA32(RET_PK(c, d), bz1, S[dt]); __builtin_amdgcn_sched_barrier(0); } while (0)
                    s16x4 a0, a1, a2, a3, b0, b1, b2, b3;
                    RET_RD(0, a0, a1, a2, a3); RET_RD(1, b0, b1, b2, b3);
                    RET_WAIT4();
                    const bf16x8 bz0 = RET_PK(zl0, zh0), bz1 = RET_PK(zl1, zh1);
                    RET_UP(0, a0, a1, a2, a3); RET_RD(2, a0, a1, a2, a3); RET_WAIT4();
                    RET_UP(1, b0, b1, b2, b3); RET_RD(3, b0, b1, b2, b3); RET_WAIT4();
                    RET_UP(2, a0, a1, a2, a3); RET_RD(4, a0, a1, a2, a3); RET_WAIT4();
                    RET_UP(3, b0, b1, b2, b3); RET_RD(5, b0, b1, b2, b3); RET_WAIT4();
                    RET_UP(4, a0, a1, a2, a3); RET_RD(6, a0, a1, a2, a3); RET_WAIT4();
                    RET_UP(5, b0, b1, b2, b3); RET_RD(7, b0, b1, b2, b3); RET_WAIT4();
                    RET_UP(6, a0, a1, a2, a3); RET_LWAIT();
                    RET_UP(7, b0, b1, b2, b3);
#undef RET_RD
#undef RET_WAIT4
#undef RET_UP
                }
                RET_BAR();
            }
            RET_BAR();
        } else {
            int lt = tid - 256; asm volatile("" : "+v"(lt));
            const __amdgpu_buffer_rsrc_t srd = __builtin_amdgcn_make_buffer_rsrc((void*)qkv, (short)0, (int)((size_t)36864 * LDQKV * 2), 0x00020000);
            unsigned vq[4], vv[2];
#pragma unroll
            for (int i = 0; i < 4; ++i) { const int id = lt + 256 * i, row = id >> 5, ch = id & 31; vq[i] = (unsigned)(row * LDQKV + ch * 8) * 2u; }
#pragma unroll
            for (int i = 0; i < 2; ++i) { const int id = lt + 256 * i, row = id >> 4, ch = id & 15; vv[i] = (unsigned)(row * LDQKV + 2048 + ch * 8) * 2u; }
            const unsigned sq0 = (unsigned)((rowbase * LDQKV + h * 256) * 2), sv0 = (unsigned)((rowbase * LDQKV + h * 512 + eq * 128) * 2);
            RET_LAS unsigned char* lq[4]; RET_LAS unsigned char* lk[4]; RET_LAS unsigned char* lv[2];
#pragma unroll
            for (int i = 0; i < 4; ++i) { const int id = lt + 256 * i, row = id >> 5, ch = id & 31; lq[i] = lds + Q_OFF + row * QS + ch * 16; lk[i] = lds + K_OFF + row * KS + ch * 16; }
#pragma unroll
            for (int i = 0; i < 2; ++i) { const int id = lt + 256 * i, row = id >> 4, ch = id & 15; lv[i] = lds + V_OFF + row * VS + ch * 16; }
            float zz[2];
#pragma unroll
            for (int i = 0; i < 2; ++i) { const int row = (lt + 256 * i) >> 4; zz[i] = __builtin_amdgcn_exp2f(lg2 * (float)(sweep ? T - 1 - row : row)); }
            const int yc = lt >> 3, ye = (lt & 7) * 16;
            bf16_t* yg = Y + rowbase * LDY + h * 512 + eq * 128 + ye;
            u32x4 rq[3][4], rk[3][4], rv[3][2];
#define RET_LOAD(set_, sidx_) do { const unsigned so_ = (unsigned)(sidx_) * (unsigned)(T * LDQKV * 2); \
                _Pragma("unroll") for (int i = 0; i < 4; ++i) { \
                    rq[set_][i] = __builtin_bit_cast(u32x4, __builtin_amdgcn_raw_buffer_load_b128(srd, (int)vq[i], (int)(so_ + sq0), 0)); \
                    rk[set_][i] = __builtin_bit_cast(u32x4, __builtin_amdgcn_raw_buffer_load_b128(srd, (int)vq[i], (int)(so_ + sq0 + 2048u), 0)); } \
                _Pragma("unroll") for (int i = 0; i < 2; ++i) rv[set_][i] = __builtin_bit_cast(u32x4, __builtin_amdgcn_raw_buffer_load_b128(srd, (int)vv[i], (int)(so_ + sv0), 0)); } while (0)
#define RET_STAGE(set_, stage_) do { \
                _Pragma("unroll") for (int i = 0; i < 4; ++i) { \
                    *(RET_LAS u32x2*)(lq[i] + (stage_) * STG) = (u32x2){rq[set_][i].x, rq[set_][i].y}; *(RET_LAS u32x2*)(lq[i] + (stage_) * STG + 8) = (u32x2){rq[set_][i].z, rq[set_][i].w}; \
                    *(RET_LAS u32x4*)(lk[i] + (stage_) * STG) = rk[set_][i]; } \
                _Pragma("unroll") for (int i = 0; i < 2; ++i) { const float z = zz[i]; \
                    *(RET_LAS u32x4*)(lv[i] + (stage_) * STG) = rv[set_][i]; \
                    u32x4 o; o.x = pk2(bflo(rv[set_][i].x) * z, bfhi(rv[set_][i].x) * z); o.y = pk2(bflo(rv[set_][i].y) * z, bfhi(rv[set_][i].y) * z); \
                    o.z = pk2(bflo(rv[set_][i].z) * z, bfhi(rv[set_][i].z) * z); o.w = pk2(bflo(rv[set_][i].w) * z, bfhi(rv[set_][i].w) * z); \
                    *(RET_LAS u32x4*)(lv[i] + (stage_) * STG + (VZ_OFF - V_OFF)) = o; } } while (0)
#define RET_DRAIN(buf_, sidx_) do { const RET_LAS unsigned char* yp_ = lds + YT_OFF + (buf_) * YT_BYTES + yc * YS + ye * 4; \
                const f32x4 a0_ = *(const RET_LAS f32x4*)(yp_), a1_ = *(const RET_LAS f32x4*)(yp_ + 16), a2_ = *(const RET_LAS f32x4*)(yp_ + 32), a3_ = *(const RET_LAS f32x4*)(yp_ + 48); \
                float yv_[16] = {a0_[0], a0_[1], a0_[2], a0_[3], a1_[0], a1_[1], a1_[2], a1_[3], a2_[0], a2_[1], a2_[2], a2_[3], a3_[0], a3_[1], a3_[2], a3_[3]}; \
                bf16_t* gp_ = yg + ((size_t)(sidx_) * T + yc) * LDY; \
                if (sweep) { const u32x4 o0_ = yb0, o1_ = yb1; \
                    yv_[0] += bflo(o0_.x); yv_[1] += bfhi(o0_.x); yv_[2] += bflo(o0_.y); yv_[3] += bfhi(o0_.y); yv_[4] += bflo(o0_.z); yv_[5] += bfhi(o0_.z); yv_[6] += bflo(o0_.w); yv_[7] += bfhi(o0_.w); \
                    yv_[8] += bflo(o1_.x); yv_[9] += bfhi(o1_.x); yv_[10] += bflo(o1_.y); yv_[11] += bfhi(o1_.y); yv_[12] += bflo(o1_.z); yv_[13] += bfhi(o1_.z); yv_[14] += bflo(o1_.w); yv_[15] += bfhi(o1_.w); \
                    float s1_ = 0.f, s2_ = 0.f; \
                    _Pragma("unroll") for (int i = 0; i < 16; ++i) { s1_ += yv_[i]; s2_ += yv_[i] * yv_[i]; } \
                    s1_ += dpp_f<0xB1>(s1_); s2_ += dpp_f<0xB1>(s2_); s1_ += dpp_f<0x4E>(s1_); s2_ += dpp_f<0x4E>(s2_); s1_ += dpp_f<0x141>(s1_); s2_ += dpp_f<0x141>(s2_);     \
                    if ((lt & 7) == 0) *(f32x2*)(PSt + (((rowbase + (size_t)(sidx_) * T + yc) * 4 + h) * 4 + eq) * 2) = (f32x2){s1_, s2_}; } \
                u32x4 w0_, w1_; w0_.x = pk2(yv_[0], yv_[1]); w0_.y = pk2(yv_[2], yv_[3]); w0_.z = pk2(yv_[4], yv_[5]); w0_.w = pk2(yv_[6], yv_[7]); \
                w1_.x = pk2(yv_[8], yv_[9]); w1_.y = pk2(yv_[10], yv_[11]); w1_.z = pk2(yv_[12], yv_[13]); w1_.w = pk2(yv_[14], yv_[15]); \
                *(u32x4*)gp_ = w0_; *(u32x4*)(gp_ + 8) = w1_; } while (0)
            u32x4 yb0 = (u32x4){0u, 0u, 0u, 0u}, yb1 = (u32x4){0u, 0u, 0u, 0u};
#define RET_YPRE(sidx_) do { if (sweep) { const bf16_t* gq_ = yg + ((size_t)(sidx_) * T + yc) * LDY; yb0 = *(const u32x4*)gq_; yb1 = *(const u32x4*)(gq_ + 8); } } while (0)
            RET_LOAD(0, RET_SIDX(0)); RET_STAGE(0, 0); RET_LOAD(0, RET_SIDX(1)); RET_LOAD(1, RET_SIDX(2)); RET_LOAD(2, RET_SIDX(3));
            RET_BAR();
#define RET_LITER(it_, set_, stage_) do { \
                if (!(VAR & 1) && (it_) >= 1) RET_DRAIN(((it_) - 1) & 1, RET_SIDX((it_) - 1));     \
                if (!(VAR & 1)) RET_YPRE(RET_SIDX(it_));              \
                RET_BAR();                                      \
                if (!(VAR & 8) && (it_) + 1 < NS) RET_STAGE(set_, stage_);     \
                if (!(VAR & 8) && (it_) + 4 < NS) RET_LOAD(set_, RET_SIDX((it_) + 4)); \
                RET_BAR();                                      } while (0)
            for (int it = 0; it < NS; it += 6) { RET_LITER(it, 0, 1); RET_LITER(it + 1, 1, 0); RET_LITER(it + 2, 2, 1); RET_LITER(it + 3, 0, 0); RET_LITER(it + 4, 1, 1); RET_LITER(it + 5, 2, 0); }
#undef RET_LITER
            RET_DRAIN((NS - 1) & 1, RET_SIDX(NS - 1));
            RET_BAR();
#undef RET_LOAD
#undef RET_STAGE
#undef RET_DRAIN
#undef RET_YPRE
        }
        asm volatile("s_waitcnt vmcnt(0)" ::: "memory");
        __threadfence();
        __syncthreads();
    }
}
}
#ifndef DUP_ATT
#define DUP_ATT 0
#endif
#ifndef DUP_RET
#define DUP_RET 0
#endif
constexpr int NWAVES = 8, NTHR = 512;
constexpr int NB = 32, SEQ = 2048, DM = 1024, CTX = 256, SL = 2304;
constexpr int MROWS = NB * SL, HROWS = MROWS / 2;
constexpr int NMOD = 6 * DM;
constexpr int RET_IN = 6144, RET_QKV = 4096, RET_V = 2048;
constexpr int ATT_IN = 1536;
constexpr int NEXP = 32, EHID = 512;
constexpr int MAXTILES = 608, MAXSLOTS = MAXTILES * 256;
constexpr float NORM_EPS = 1e-6f, HEAD_EPS = 1e-5f;

constexpr size_t MiB = 1u << 20;
constexpr size_t WS_CTL = 0, CTL_ZERO_BYTES = 1 * MiB;
constexpr size_t WS_MODP = 1 * MiB;
constexpr size_t WS_DROW = 1 * MiB;
constexpr size_t WS_MOD = 14 * MiB;
constexpr size_t WS_TR = 16 * MiB;
constexpr size_t WS_TA = WS_TR + 64 * 64 * 8;
constexpr size_t WS_QKG = WS_TR + 64 * 64 * 8 + 64 * 32 * 8;
constexpr size_t WS_CT = 17 * MiB;
constexpr size_t WS_RT = 18 * MiB;
constexpr size_t WS_PS = 22 * MiB;
constexpr size_t WS_WE2 = 31 * MiB + 512 * 1024;
constexpr size_t WS_SROW = 21 * MiB + 65536;
constexpr size_t WS_TILE = 21 * MiB;
constexpr size_t WS_WIN = 32 * MiB, WS_WOUT = 44 * MiB, WS_WQKV = 48 * MiB, WS_WO = 51 * MiB;
constexpr size_t WS_WGU = 56 * MiB;
constexpr size_t WS_WD = 184 * MiB;
constexpr size_t WS_XC = 248 * MiB;
constexpr size_t WS_BIG = 280 * MiB;
constexpr size_t WS_H0 = WS_BIG;
constexpr size_t WS_QKV0 = WS_BIG + 144 * MiB;
constexpr size_t WS_Y0 = WS_BIG + 432 * MiB;
constexpr size_t WS_A2 = WS_QKV0;
constexpr size_t WS_H2_0 = WS_BIG;
constexpr size_t WS_AS = WS_BIG + 144 * MiB;
constexpr size_t WS_HD = WS_BIG + 448 * MiB;
constexpr size_t WS_YS = WS_AS;
constexpr size_t WS_H1 = WS_BIG;
constexpr size_t WS_QKV1 = WS_BIG + 144 * MiB;
constexpr size_t WS_AO = WS_BIG + 360 * MiB;
constexpr size_t WS_KC = WS_BIG + 648 * MiB;
constexpr size_t WS_VC = WS_BIG + 684 * MiB;
constexpr size_t WS_H2_1 = WS_BIG + 504 * MiB;
constexpr size_t WS_AS1 = WS_BIG + 144 * MiB;
constexpr size_t WS_HD1 = WS_BIG;
constexpr size_t WS_YS1 = WS_BIG + 416 * MiB;
constexpr size_t WS_END = 1000 * MiB;
constexpr int CW_TMO = 0, CW_CODE = 1;
constexpr int CW_BAR = 4096, BAR_STRIDE = 3584;
constexpr int MAX_LAUNCH = 40;
constexpr int CW_PCNT0 = 163840, CW_PCNT1 = 196608, CW_NEXT0 = 229376, CW_NEXT1 = 229440, CW_RTMO = 2;
static_assert((CW_BAR + MAX_LAUNCH * BAR_STRIDE) <= CW_PCNT0 && CW_PCNT0 + 288 * 64 <= CW_PCNT1 && CW_PCNT1 + 256 * 64 <= CW_NEXT0 && (CW_NEXT1 + 64) * 4 <= (int)CTL_ZERO_BYTES, "control words inside the memset");

constexpr int RING_BYTES = 155648;
constexpr int MISC_OFF = RING_BYTES;
constexpr int LDS_BYTES = 160 * 1024;
static_assert(ret::LDS_END <= RING_BYTES && (int)att::SHM_ATTN <= RING_BYTES && pg8::STAGE_BYTES <= RING_BYTES && MISC_OFF + 4096 <= LDS_BYTES, "LDS map");

#define GAS __attribute__((address_space(1)))
#define LAS __attribute__((address_space(3)))
typedef unsigned short bf16;
typedef unsigned v4u __attribute__((ext_vector_type(4)));
typedef unsigned v2u __attribute__((ext_vector_type(2)));
typedef float f32x4 __attribute__((ext_vector_type(4)));
typedef float f32x2 __attribute__((ext_vector_type(2)));
typedef GAS unsigned gu32;
#define RLX_AGENT __ATOMIC_RELAXED, __HIP_MEMORY_SCOPE_AGENT
#define LDS_WAIT() asm volatile("s_waitcnt lgkmcnt(0)" ::: "memory")
#define DI __device__ __forceinline__
DI unsigned f2bf(float f) { unsigned u = __builtin_bit_cast(unsigned, f); return (u + 0x7fffu + ((u >> 16) & 1u)) >> 16; }
DI unsigned pk2(float lo, float hi) { return f2bf(lo) | (f2bf(hi) << 16); }
DI float bflo(unsigned w) { return __builtin_bit_cast(float, w << 16); }
DI float bfhi(unsigned w) { return __builtin_bit_cast(float, w & 0xffff0000u); }
DI float silu_f(float x) { return x / (1.0f + __expf(-x)); }

#define XB_TMO      128
#define XB_XCNT(j)  (256  + 64 * (j))
#define XB_XSUB(j)  (1280 + 64 * (j))
#define XB_XGEN(j)  (2304 + 64 * (j))
#define XB_TOP      3328
#define XB_TOPGEN   3392
#define XCD_BAR_WORDS 3456
#define XB_SPIN_CAP (1u << 18)
#define LAS __attribute__((address_space(3)))

__device__ __forceinline__ unsigned xb_ld(unsigned* p)              { return __hip_atomic_load(p, __ATOMIC_RELAXED, __HIP_MEMORY_SCOPE_AGENT); }
__device__ __forceinline__ unsigned xb_add(unsigned* p, unsigned v) { return __hip_atomic_fetch_add(p, v, __ATOMIC_RELAXED, __HIP_MEMORY_SCOPE_AGENT); }
__device__ __forceinline__ unsigned xb_xcc_id() { return (unsigned)__builtin_amdgcn_s_getreg((3 << 11) | 20) & 0xFu; }
#define XB_SPIN(cond, bar) do { unsigned _sp = 0; while (cond) { __builtin_amdgcn_s_sleep(1); \
    if ((++_sp & 255u) == 0u) { if (xb_ld(&(bar)[XB_TMO])) break; if (_sp > XB_SPIN_CAP) { atomicAdd(&(bar)[XB_TMO], 1u); break; } } } } while (0)

struct XcdBarrier {
    unsigned* bar; unsigned x;
    volatile LAS unsigned* st;
};

__device__ __forceinline__ XcdBarrier xcd_barrier_post(unsigned* bar, volatile LAS unsigned* st) {
    XcdBarrier b; b.bar = bar; b.x = xb_xcc_id(); b.st = st;
    if (threadIdx.x == 0) (void)xb_add(&bar[XB_XCNT(b.x)], 1u);
    return b;
}
__device__ __forceinline__ void xcd_barrier_complete(unsigned* bar, unsigned x, unsigned& nloc, unsigned& nx) {
    const unsigned G = gridDim.x * gridDim.y * gridDim.z;
    unsigned sum, cnt, mine, sp = 0u;
    for (;;) {
        sum = 0u; cnt = 0u; mine = 0u;
#pragma unroll
        for (unsigned j = 0; j < 16; ++j) { const unsigned c = xb_ld(&bar[XB_XCNT(j)]); sum += c; cnt += (c > 0u) ? 1u : 0u; mine = (j == x) ? c : mine; }
        if (sum == G) break;
        __builtin_amdgcn_s_sleep(1);
        if ((++sp & 255u) == 0u) { if (xb_ld(&bar[XB_TMO])) break; if (sp > XB_SPIN_CAP) { atomicAdd(&bar[XB_TMO], 1u); break; } }
    }
    nloc = mine > 0u ? mine : 1u; nx = cnt > 0u ? cnt : 1u;
}

__device__ __forceinline__ void xcd_barrier(const XcdBarrier& b) {
    asm volatile("s_waitcnt vmcnt(0)" ::: "memory");
    __syncthreads();
    if (threadIdx.x == 0) {
        unsigned* bar = b.bar;
        __builtin_amdgcn_s_waitcnt(0);
        unsigned nloc = b.st[0], nx = b.st[1];
        if (nloc == 0u) { xcd_barrier_complete(bar, b.x, nloc, nx); b.st[0] = nloc; b.st[1] = nx; }
        const unsigned old = xb_add(&bar[XB_XSUB(b.x)], 1u);
        const unsigned gen = old / nloc;
        if (old + 1u == (gen + 1u) * nloc) {
            __builtin_amdgcn_fence(__ATOMIC_RELEASE, "agent");
            asm volatile("s_waitcnt vmcnt(0)" ::: "memory");
            const unsigned og = xb_add(&bar[XB_TOP], 1u);
            const unsigned tg = og / nx;
            if (og + 1u == (tg + 1u) * nx) xb_add(&bar[XB_TOPGEN], 1u);
            else XB_SPIN(xb_ld(&bar[XB_TOPGEN]) == tg, bar);
            __builtin_amdgcn_fence(__ATOMIC_ACQUIRE, "agent");
            xb_add(&bar[XB_XGEN(b.x)], 1u);
            asm volatile("s_waitcnt vmcnt(0)" ::: "memory");
        } else {
            XB_SPIN(xb_ld(&bar[XB_XGEN(b.x)]) == gen, bar);
            __builtin_amdgcn_fence(__ATOMIC_ACQUIRE, "agent");
            asm volatile("s_waitcnt vmcnt(0)" ::: "memory");
        }
    }
    __syncthreads();
}

template <int N> __device__ __forceinline__ void wave_sum_n(float (&v)[N]) {
#pragma unroll
    for (int o = 1; o < 64; o <<= 1) { float t[N];
#pragma unroll
        for (int i = 0; i < N; ++i) t[i] = __shfl_xor(v[i], o);
#pragma unroll
        for (int i = 0; i < N; ++i) v[i] += t[i]; }
}


struct Args { const float* in[22]; float* out; unsigned char* ws; int ph_lo, ph_hi, li, pad; };
#define CAS __attribute__((address_space(4)))
struct Frame {
    const CAS Args* ap;
    LAS unsigned char* lds;
    volatile LAS unsigned* MISC;
    gu32* ctl;
    int tid, lane, wave;
    int vcu, G;
    float* out; unsigned char* ws;
};
DI float wave_sum(float v) {
#pragma unroll
    for (int o = 1; o < 64; o <<= 1) v += __shfl_xor(v, o);
    return v;
}
template <int MODE = 0> __device__ __forceinline__ void p0_transpose_item(const float* W, int K, int N, bf16* WT, int row_off, LAS float* scr, int item, int lane) {
    const int nblk = N / 32, kb = item / nblk, nb = item % nblk, k0 = 64 * kb, n0 = 32 * nb;
#pragma unroll 32
    for (int i = 0; i < 32; ++i) { const int kk = 2 * i + (lane >> 5); scr[kk * 33 + (lane & 31)] = __builtin_nontemporal_load(W + (size_t)(k0 + kk) * N + n0 + (lane & 31)); }
    LDS_WAIT(); asm volatile("" ::: "memory");
    const int c = lane & 7;
#pragma unroll
    for (int j = 0; j < 4; ++j) { const int n = (lane >> 3) + 8 * j; const LAS float* s = scr + (8 * c) * 33 + n;
        v4u o; o.x = pk2(s[0 * 33], s[1 * 33]); o.y = pk2(s[2 * 33], s[3 * 33]); o.z = pk2(s[4 * 33], s[5 * 33]); o.w = pk2(s[6 * 33], s[7 * 33]);
        const int nn = n0 + n;
        const int drow = MODE == 1 ? ((nn >> 2) * 8 + (nn & 3) + row_off) : (MODE == 2 && nn < 2048) ? ((nn & ~127) + 2 * (nn & 63) + ((nn >> 6) & 1)) : (MODE == 3 && nn < 1280) ? ((nn & ~63) + 2 * (nn & 31) + ((nn >> 5) & 1)) : (row_off + nn);
        *(GAS v4u*)(WT + (size_t)drow * K + k0 + 8 * c) = o; }
    LDS_WAIT(); asm volatile("" ::: "memory");
}


DI const float* src_row0(const Frame& F, int r) { const int b = r / SL, s = r - b * SL; return s < CTX ? F.ap->in[2] + ((size_t)b * CTX + s) * DM : F.ap->in[0] + ((size_t)b * SEQ + (s - CTX)) * DM; }
DI float* xs_row(const Frame& F, int r) { const int b = r / SL, s = r - b * SL; return s < CTX ? (float*)(F.ws + WS_XC) + ((size_t)b * CTX + s) * DM : F.out + ((size_t)b * SEQ + (s - CTX)) * DM; }
DI const float* mod_row(const Frame& F, int layer, int r) { const int b = r / SL, s = r - b * SL; return (const float*)(F.ws + WS_MOD) + ((size_t)layer * 33 + (s < CTX ? 32 : b)) * NMOD; }

DI void ld_row(const float* p, int lane, f32x4 (&v)[4]) {
#pragma unroll
    for (int j = 0; j < 4; ++j) v[j] = __builtin_nontemporal_load((const f32x4*)(p + 4 * lane + 256 * j));
}
DI void st_row(float* p, int lane, const f32x4 (&v)[4]) {
#pragma unroll
    for (int j = 0; j < 4; ++j) __builtin_nontemporal_store(v[j], (f32x4*)(p + 4 * lane + 256 * j));
}
DI void st_row_bf16(bf16* p, int lane, const f32x4 (&v)[4]) {
#pragma unroll
    for (int j = 0; j < 4; ++j) { v2u o; o.x = pk2(v[j][0], v[j][1]); o.y = pk2(v[j][2], v[j][3]); *(v2u*)(p + 4 * lane + 256 * j) = o; }
}
DI void ld_row_bf16(const bf16* p, int lane, f32x4 (&v)[4]) {
#pragma unroll
    for (int j = 0; j < 4; ++j) { const v2u o = *(const v2u*)(p + 4 * lane + 256 * j); v[j] = (f32x4){bflo(o.x), bfhi(o.x), bflo(o.y), bfhi(o.y)}; }
}
DI float row_rinv(const f32x4 (&v)[4]) {
    float s = 0.f;
#pragma unroll
    for (int j = 0; j < 4; ++j) s += (v[j][0] * v[j][0] + v[j][1] * v[j][1]) + (v[j][2] * v[j][2] + v[j][3] * v[j][3]);
    return 1.0f / sqrtf(wave_sum(s) * (1.0f / DM) + NORM_EPS);
}
template <int NR> DI void rows_rinv(const f32x4 (&x)[NR][4], float (&rinv)[NR]) {
#pragma unroll
    for (int k = 0; k < NR; ++k) { float s = 0.f;
#pragma unroll
        for (int j = 0; j < 4; ++j) s += (x[k][j][0] * x[k][j][0] + x[k][j][1] * x[k][j][1]) + (x[k][j][2] * x[k][j][2] + x[k][j][3] * x[k][j][3]);
        rinv[k] = s; }
    wave_sum_n<NR>(rinv);
#pragma unroll
    for (int k = 0; k < NR; ++k) rinv[k] = 1.0f / sqrtf(rinv[k] * (1.0f / DM) + NORM_EPS);
}
struct ModVec { f32x4 sh[4], sc[4]; };
DI void modulate_apply(const f32x4 (&x)[4], float rinv, const ModVec& mv, f32x4 (&h)[4]) {
#pragma unroll
    for (int j = 0; j < 4; ++j) h[j] = x[j] * rinv * (mv.sc[j] + 1.0f) + mv.sh[j];
}
DI void ld_modvec(const float* __restrict__ mod, int sh_off, int lane, ModVec& mv) {
#pragma unroll
    for (int j = 0; j < 4; ++j) { mv.sh[j] = *(const f32x4*)(mod + sh_off + 4 * lane + 256 * j); mv.sc[j] = *(const f32x4*)(mod + sh_off + DM + 4 * lane + 256 * j); }
}
DI void modulate_vec(const f32x4 (&x)[4], const ModVec& mv, f32x4 (&h)[4]) {
    const float rinv = row_rinv(x);
#pragma unroll
    for (int j = 0; j < 4; ++j) h[j] = x[j] * rinv * (mv.sc[j] + 1.0f) + mv.sh[j];
}
template <int NR> DI void route_rows(const Frame& F, int layer, const f32x4 (&h)[NR][4], int lane, int (&e0)[NR], int (&e1)[NR], float (&g0)[NR], float (&g1)[NR]) {
    const LAS float* bg = (const LAS float*)(F.lds + 147456); const LAS float* be = bg + 4;
    const LAS float* Lg = (const LAS float*)(F.lds) + lane * 4;
    const LAS float* Le = (const LAS float*)(F.lds + 16384) + lane * 4;
    float gl[NR * 4];
#pragma unroll
    for (int i = 0; i < NR * 4; ++i) gl[i] = 0.f;
#pragma unroll
    for (int j = 0; j < 4; ++j)
#pragma unroll
        for (int i = 0; i < 4; ++i) { const f32x4 w = *(const LAS f32x4*)(Lg + (j * 4 + i) * 256);
#pragma unroll
            for (int k = 0; k < NR; ++k) { const float x = h[k][j][i]; gl[4 * k + 0] += x * w[0]; gl[4 * k + 1] += x * w[1]; gl[4 * k + 2] += x * w[2]; gl[4 * k + 3] += x * w[3]; } }
    wave_sum_n<NR * 4>(gl);
    int gi[NR]; float gp[NR];
#pragma unroll
    for (int k = 0; k < NR; ++k) { const float a0 = gl[4 * k] + bg[0], a1 = gl[4 * k + 1] + bg[1], a2 = gl[4 * k + 2] + bg[2], a3 = gl[4 * k + 3] + bg[3];
        int gidx = 0; float gm = a0; if (a1 > gm) { gm = a1; gidx = 1; } if (a2 > gm) { gm = a2; gidx = 2; } if (a3 > gm) { gm = a3; gidx = 3; }
        gp[k] = 1.0f / (__expf(a0 - gm) + __expf(a1 - gm) + __expf(a2 - gm) + __expf(a3 - gm)); gi[k] = __builtin_amdgcn_readfirstlane(gidx); }
    float el[NR * 8];
#pragma unroll
    for (int i = 0; i < NR * 8; ++i) el[i] = 0.f;
#pragma unroll
    for (int k = 0; k < NR; ++k) { const LAS float* wk = Le + gi[k] * 8192;
#pragma unroll
        for (int j = 0; j < 4; ++j)
#pragma unroll
            for (int i = 0; i < 4; ++i) { const f32x4 a = *(const LAS f32x4*)(wk + ((j * 4 + i) * 2) * 256), b = *(const LAS f32x4*)(wk + ((j * 4 + i) * 2 + 1) * 256); const float x = h[k][j][i];
                el[8 * k + 0] += x * a[0]; el[8 * k + 1] += x * a[1]; el[8 * k + 2] += x * a[2]; el[8 * k + 3] += x * a[3]; el[8 * k + 4] += x * b[0]; el[8 * k + 5] += x * b[1]; el[8 * k + 6] += x * b[2]; el[8 * k + 7] += x * b[3]; } }
    wave_sum_n<NR * 8>(el);
#pragma unroll
    for (int k = 0; k < NR; ++k) { float ev[8];
#pragma unroll
        for (int c = 0; c < 8; ++c) ev[c] = el[8 * k + c] + be[8 * gi[k] + c];
        int t1 = 0; float m1 = ev[0];
#pragma unroll
        for (int c = 1; c < 8; ++c) if (ev[c] > m1) { m1 = ev[c]; t1 = c; }
        int t2 = -1; float m2 = -3.0e38f;
#pragma unroll
        for (int c = 0; c < 8; ++c) if (c != t1 && ev[c] > m2) { m2 = ev[c]; t2 = c; }
        if (t2 < 0) t2 = (t1 + 1) & 7;
        const float p2 = __expf(m2 - m1), inv = 1.0f / (1.0f + p2);
        g0[k] = gp[k] * inv; g1[k] = gp[k] * p2 * inv; e0[k] = 8 * gi[k] + t1; e1[k] = 8 * gi[k] + t2; }
}

constexpr int P0I_WIN = 16 * 192, P0I_WOUT = 32 * 32, P0I_WQKV = 16 * 48, P0I_WO = 16 * 32, P0I_DENSE = P0I_WIN + P0I_WOUT + P0I_WQKV + P0I_WO, P0I_MOE1 = 768, P0_NITEMS = P0I_DENSE + 64 * P0I_MOE1;
struct P0Desc { const float* src; bf16* dst; int K, N, mode, row_off, item; };
DI P0Desc p0_decode(const Frame& F, int it) {
    int r = it;
    if (r < P0I_WIN) return P0Desc{F.ap->in[6], (bf16*)(F.ws + WS_WIN), DM, RET_IN, 2, 0, r}; r -= P0I_WIN;
    if (r < P0I_WOUT) return P0Desc{F.ap->in[7], (bf16*)(F.ws + WS_WOUT), RET_V, DM, 0, 0, r}; r -= P0I_WOUT;
    if (r < P0I_WQKV) return P0Desc{F.ap->in[10], (bf16*)(F.ws + WS_WQKV), DM, ATT_IN, 3, 0, r}; r -= P0I_WQKV;
    if (r < P0I_WO) return P0Desc{F.ap->in[11], (bf16*)(F.ws + WS_WO), DM, DM, 0, 0, r}; r -= P0I_WO;
    const int le = r / P0I_MOE1, rem = r - le * P0I_MOE1, which = rem >> 8, sub = rem & 255;
    if (which == 0) return P0Desc{F.ap->in[18] + (size_t)le * DM * EHID, (bf16*)(F.ws + WS_WGU) + (size_t)le * 1024 * 1024, DM, EHID, 1, 0, sub};
    if (which == 1) return P0Desc{F.ap->in[19] + (size_t)le * DM * EHID, (bf16*)(F.ws + WS_WGU) + (size_t)le * 1024 * 1024, DM, EHID, 1, 4, sub};
    return P0Desc{F.ap->in[20] + (size_t)le * EHID * DM, (bf16*)(F.ws + WS_WD) + (size_t)le * 1024 * 512, EHID, DM, 0, 0, sub};
}
DI void p0_issue(const P0Desc& d, int lane, f32x4 (&v)[8]) {
    const int nblk = d.N / 32, kb = d.item / nblk, nb = d.item - kb * nblk;
    const float* p = d.src + (size_t)(64 * kb + (lane >> 3)) * d.N + 32 * nb + 4 * (lane & 7);
#pragma unroll
    for (int i = 0; i < 8; ++i) v[i] = __builtin_nontemporal_load((const f32x4*)(p + (size_t)(8 * i) * d.N));
    __builtin_amdgcn_sched_barrier(0);
}
DI void p0_finish(const P0Desc& d, int lane, const f32x4 (&v)[8], LAS float* scr) {
    const int nblk = d.N / 32, kb = d.item / nblk, nb = d.item - kb * nblk, k0 = 64 * kb, n0 = 32 * nb;
#pragma unroll
    for (int i = 0; i < 8; ++i) { LAS float* w = scr + (8 * i + (lane >> 3)) * 33 + 4 * (lane & 7); w[0] = v[i][0]; w[1] = v[i][1]; w[2] = v[i][2]; w[3] = v[i][3]; }
    LDS_WAIT(); asm volatile("" ::: "memory");
    const int c = lane & 7;
#pragma unroll
    for (int j = 0; j < 4; ++j) { const int n = (lane >> 3) + 8 * j; const LAS float* s = scr + (8 * c) * 33 + n;
        v4u o; o.x = pk2(s[0 * 33], s[1 * 33]); o.y = pk2(s[2 * 33], s[3 * 33]); o.z = pk2(s[4 * 33], s[5 * 33]); o.w = pk2(s[6 * 33], s[7 * 33]);
        const int nn = n0 + n;
        const int drow = d.mode == 1 ? ((nn >> 2) * 8 + (nn & 3) + d.row_off) : (d.mode == 2 && nn < 2048) ? ((nn & ~127) + 2 * (nn & 63) + ((nn >> 6) & 1)) : (d.mode == 3 && nn < 1280) ? ((nn & ~63) + 2 * (nn & 31) + ((nn >> 5) & 1)) : (d.row_off + nn);
        *(GAS v4u*)(d.dst + (size_t)drow * d.K + k0 + 8 * c) = o; }
    LDS_WAIT(); asm volatile("" ::: "memory");
}
template <class Map> DI void p0_run(const Frame& F, int lo, int hi, int stride, Map map) {
    if (lo >= hi) return;
    LAS float* scr = (LAS float*)(F.lds + F.wave * 16384);
    f32x4 va[8], vb[8]; P0Desc da = p0_decode(F, map(lo)), db; int i = lo;
    p0_issue(da, F.lane, va);
    while (i + 2 * stride < hi) { db = p0_decode(F, map(i + stride)); p0_issue(db, F.lane, vb); p0_finish(da, F.lane, va, scr); da = p0_decode(F, map(i + 2 * stride)); p0_issue(da, F.lane, va); p0_finish(db, F.lane, vb, scr); i += 2 * stride; }
    if (i + stride < hi) { db = p0_decode(F, map(i + stride)); p0_issue(db, F.lane, vb); p0_finish(da, F.lane, va, scr); p0_finish(db, F.lane, vb, scr); } else p0_finish(da, F.lane, va, scr);
}
constexpr int P0D_L0 = P0I_WOUT + 32 * P0I_MOE1, P0D_DENSE1 = P0D_L0 + P0I_WQKV + P0I_WO, P0D_TOTAL = P0_NITEMS - P0I_WIN;
#ifndef BG3
#define BG3 3072
#endif
#ifndef BG5
#define BG5 3072
#endif
#ifndef BG7
#define BG7 6144
#endif
#ifndef BG8
#define BG8 14336
#endif
#ifndef BG15
#define BG15 4096
#endif
constexpr int BG3_LO = 0, BG5_LO = BG3_LO + BG3, BG7_LO = BG5_LO + BG5, BG8_LO = BG7_LO + BG7, BG_END = BG8_LO + BG8, BG15_LO = P0D_TOTAL - BG15;
static_assert(BG_END <= BG15_LO, "deferred list overrun"); static_assert(BG8 == 0 || BG8_LO >= P0I_WOUT, "W_out must be complete before the out projection (phase 8) starts");
static_assert(BG15 == 0 || BG15_LO >= P0D_DENSE1, "phase 15's chunk may hold layer-1 expert weights only");
DI int p0_deferred_phys(int d) {
    if (d < P0I_WOUT) return P0I_WIN + d;
    if (d < P0D_L0) return P0I_DENSE + (d - P0I_WOUT);
    if (d < P0D_DENSE1) return P0I_WIN + P0I_WOUT + (d - P0D_L0);
    return P0I_DENSE + 32 * P0I_MOE1 + (d - P0D_DENSE1);
}
DI void p0_background(Frame& F, int nwg, int d_lo, int d_hi) {
    const int first = nwg % F.G, n = F.G - first;
    if ((int)blockIdx.x < first || d_hi <= d_lo) return;
    __syncthreads();
    p0_run(F, d_lo + ((int)blockIdx.x - first) * NWAVES + F.wave, d_hi, n * NWAVES, [](int d) { return p0_deferred_phys(d); });
}
DI void p0_prologue(Frame& F) {
    LAS float* Ssil = (LAS float*)(F.lds + 131072);
    for (int vw = blockIdx.x; vw < 256; vw += F.G) {
        const int kq = vw & 7, grp = vw >> 3;
        __syncthreads();
        { float cv[9];
#pragma unroll
          for (int q = 0; q < 9; ++q) { const int idx = min(F.tid + q * NTHR, 33 * 128 - 1), m = idx >> 7, k = idx & 127; const float* src = m < 32 ? F.ap->in[1] + (size_t)m * DM : F.ap->in[3]; cv[q] = src[128 * kq + k]; }
#pragma unroll
          for (int q = 0; q < 9; ++q) { const int idx = F.tid + q * NTHR; if (idx < 33 * 128) Ssil[idx] = silu_f(cv[q]); } }
        __syncthreads();
        const int blk = grp * 8 + F.wave;
        if (blk < 192) {
            const int l = blk / 96, nb = blk - l * 96; const float* W = F.ap->in[4] + ((size_t)l * DM + 128 * kq) * NMOD + 64 * nb + F.lane;
            float acc[33];
#pragma unroll
            for (int m = 0; m < 33; ++m) acc[m] = 0.f;
            for (int k = 0; k < 128; k += 32) {
                float wv[32];
#pragma unroll
                for (int q = 0; q < 32; ++q) wv[q] = __builtin_nontemporal_load(W + (size_t)(k + q) * NMOD);
#pragma unroll
                for (int m = 0; m < 33; ++m) {
#pragma unroll
                    for (int q = 0; q < 32; q += 4) { const f32x4 s = *(const LAS f32x4*)(Ssil + m * 128 + k + q); acc[m] += (s[0] * wv[q] + s[1] * wv[q + 1]) + (s[2] * wv[q + 2] + s[3] * wv[q + 3]); } }
            }
            float* P = (float*)(F.ws + WS_MODP) + (((size_t)kq * 2 + l) * 33) * NMOD + 64 * nb + F.lane;
#pragma unroll
            for (int m = 0; m < 33; ++m) P[(size_t)m * NMOD] = acc[m];
        }
    }
    __syncthreads();
    { const int gt = blockIdx.x * NTHR + F.tid;
      if (gt < 64 * 64) { const int pos = gt >> 6, j = gt & 63; const float inv = __powf(10000.0f, -(float)j / 64.0f); float sn, cs; sincosf((float)pos * inv, &sn, &cs);
          ((f32x2*)(F.ws + WS_TR))[gt] = (f32x2){cs, sn}; }
      else if (gt < 64 * 64 + 64 * 32) { const int t = gt - 64 * 64, pos = t >> 5, j = t & 31; const float inv = __powf(10000.0f, -(float)j / 32.0f); float sn, cs; sincosf((float)pos * inv, &sn, &cs);
          ((f32x2*)(F.ws + WS_TA))[t] = (f32x2){cs, sn}; } }
    if (blockIdx.x == 0 && F.tid < 256) { const int which = F.tid >> 7, p = F.tid & 127, e = (p & ~63) + ((p & 63) >> 1) + 32 * (p & 1);
        ((float*)(F.ws + WS_QKG))[F.tid] = (which ? F.ap->in[13] : F.ap->in[12])[e]; }
    for (int i = blockIdx.x * NTHR + F.tid; i < 2 * DM * NEXP; i += F.G * NTHR) { const int c = i & 7, k = (i >> 3) & (DM - 1), gq = (i >> 13) & 3, l = i >> 15;
        ((float*)(F.ws + WS_WE2))[i] = F.ap->in[16][((size_t)l * DM + k) * NEXP + 8 * gq + c]; }
    p0_run(F, F.vcu * NWAVES + F.wave, P0I_WIN + (BG15_LO - BG_END), F.G * NWAVES, [](int it) { return it < P0I_WIN ? it : p0_deferred_phys(BG_END + it - P0I_WIN); });
}
DI void p0b_modreduce(Frame& F) {
    const float* P = (const float*)(F.ws + WS_MODP); float* M = (float*)(F.ws + WS_MOD);
    constexpr int NTOT = 2 * 33 * NMOD;
    for (int i0 = blockIdx.x * NTHR + F.tid; i0 < NTOT; i0 += 4 * F.G * NTHR) {
        float b[4], p[4][8];
#pragma unroll
        for (int q = 0; q < 4; ++q) { const int i = min(i0 + q * F.G * NTHR, NTOT - 1); const int l = i / (33 * NMOD), n = i % NMOD; b[q] = F.ap->in[5][(size_t)l * NMOD + n];
#pragma unroll
            for (int kq = 0; kq < 8; ++kq) p[q][kq] = P[(size_t)kq * NTOT + i]; }
#pragma unroll
        for (int q = 0; q < 4; ++q) { const int i = i0 + q * F.G * NTHR; float s = b[q];
#pragma unroll
            for (int kq = 0; kq < 8; ++kq) s += p[q][kq];
            if (i < NTOT) M[i] = s; }
    }
}
DI int seg_end(int r, int re) { const int s = r % SL; return min(re, r - s + (s < CTX ? CTX : SL)); }
DI void e1_modulate0(Frame& F) {
    const int gw = F.vcu * NWAVES + F.wave, NGW = F.G * NWAVES; bf16* __restrict__ H = (bf16*)(F.ws + WS_H0);
    constexpr int NR = 4;
    const int rpw = ((MROWS / NR + NGW - 1) / NGW) * NR, rb = gw * rpw, re = min(MROWS, rb + rpw);
    ModVec mv; f32x4 xa[NR][4], xb[NR][4];
    auto issue = [&](int r0, f32x4 (&x)[NR][4]) { const float* __restrict__ src = src_row0(F, r0);
#pragma unroll
        for (int k = 0; k < NR; ++k) ld_row(src + (size_t)k * DM, F.lane, x[k]);
        __builtin_amdgcn_sched_barrier(0); };
    auto finish = [&](int r0, f32x4 (&x)[NR][4]) {
        float rinv[NR]; rows_rinv<NR>(x, rinv);
#pragma unroll
        for (int k = 0; k < NR; ++k) { f32x4 h[4]; modulate_apply(x[k], rinv[k], mv, h); st_row_bf16(H + (size_t)(r0 + k) * DM, F.lane, h); } };
    for (int sb = rb; sb < re;) { const int se = seg_end(sb, re);
        ld_modvec(mod_row(F, 0, sb), 0, F.lane, mv);
        int r = sb; issue(r, xa); __builtin_amdgcn_s_waitcnt(0x0F70);
        while (r + 2 * NR < se) { issue(r + NR, xb); finish(r, xa); issue(r + 2 * NR, xa); finish(r + NR, xb); r += 2 * NR; }
        if (r + NR < se) { issue(r + NR, xb); finish(r, xa); finish(r + NR, xb); } else finish(r, xa);
        sb = se; }
}
DI void e_rope0(Frame& F, int hb) {
    const int gw = F.vcu * NWAVES + F.wave, NGW = F.G * NWAVES; bf16* Q = (bf16*)(F.ws + WS_QKV0); const f32x2* TR = (const f32x2*)(F.ws + WS_TR);
    const int lane = F.lane, j0 = 4 * (lane & 15); const bool second = (lane & 16) != 0, axis1 = lane >= 32;
    for (int rl = gw; rl < HROWS; rl += NGW) { const int r = hb * HROWS + rl, s = r % SL; bf16* row = Q + (size_t)rl * RET_QKV;
        if (s < CTX) {
#pragma unroll
            for (int hh = 0; hh < 4; ++hh) { v2u* p = (v2u*)(row + 1024 + hh * 256 + 4 * lane); const v2u o = *p; v2u w; w.x = pk2(bflo(o.x) * 0.0625f, bfhi(o.x) * 0.0625f); w.y = pk2(bflo(o.y) * 0.0625f, bfhi(o.y) * 0.0625f); *p = w; }
            continue; }
        const int t = s - CTX, pos = axis1 ? (t & 63) : (t >> 6);
        const f32x4 cs01 = *(const f32x4*)(TR + pos * 64 + j0), cs23 = *(const f32x4*)(TR + pos * 64 + j0 + 2);
        const float cs[4] = {cs01[0], cs01[2], cs23[0], cs23[2]}, sn[4] = {cs01[1], cs01[3], cs23[1], cs23[3]};
#pragma unroll
        for (int grp = 0; grp < 8; ++grp) {
            v2u* p = (v2u*)(row + grp * 256 + 4 * lane); const v2u o = *p; const float sc = grp >= 4 ? 0.0625f : 1.0f;
            const float x0 = bflo(o.x), x1 = bfhi(o.x), x2 = bflo(o.y), x3 = bfhi(o.y);
            const float y0 = __shfl_xor(x0, 16), y1 = __shfl_xor(x1, 16), y2 = __shfl_xor(x2, 16), y3 = __shfl_xor(x3, 16);
            const float sg = second ? 1.0f : -1.0f;
            v2u w; w.x = pk2((x0 * cs[0] + sg * y0 * sn[0]) * sc, (x1 * cs[1] + sg * y1 * sn[1]) * sc); w.y = pk2((x2 * cs[2] + sg * y2 * sn[2]) * sc, (x3 * cs[3] + sg * y3 * sn[3]) * sc);
            *p = w; }
    }
}
#ifndef RET_VAR
#define RET_VAR 0
#endif
#ifndef RET_MAINVAR
#define RET_MAINVAR 0
#endif
DI void ret_phase(Frame& F, int hb) {
    const bf16* qkv = (const bf16*)(F.ws + WS_QKV0); bf16* Y = (bf16*)(F.ws + WS_Y0) + (size_t)hb * HROWS * RET_V; float* PS = (float*)(F.ws + WS_PS) + (size_t)hb * HROWS * 32;
    if (RET_VAR) {
        for (int item = F.vcu; item < 16 * 4 * 4; item += F.G) { const int eq = item & 3, h = (item >> 2) & 3, bl = item >> 4;
            ret::ret_item<RET_VAR>(F.lds, qkv, Y, PS, bl, h, eq, F.ap->in[8][h], F.ap->in[9][h]); __syncthreads(); } }
    for (int it2 = F.vcu; it2 < 16 * 4 * 4 * (1 + DUP_RET); it2 += F.G) { const int item = it2 & 255; const int eq = item & 3, h = (item >> 2) & 3, bl = item >> 4;
        ret::ret_item<RET_MAINVAR>(F.lds, qkv, Y, PS, bl, h, eq, F.ap->in[8][h], F.ap->in[9][h]); __syncthreads(); }
}
DI void e_headnorm(Frame& F) {
    const int gw = F.vcu * NWAVES + F.wave, NGW = F.G * NWAVES; const bf16* Y = (const bf16*)(F.ws + WS_Y0); bf16* A2 = (bf16*)(F.ws + WS_A2);
    for (int rl = gw; rl < HROWS; rl += NGW) {
#pragma unroll
        for (int hh = 0; hh < 4; ++hh) { const v4u yv = *(const v4u*)(Y + (size_t)rl * RET_V + hh * 512 + 8 * F.lane); v4u* gp = (v4u*)(A2 + (size_t)rl * RET_V + hh * 512 + 8 * F.lane); const v4u gv = *gp;
            const float y[8] = {bflo(yv.x), bfhi(yv.x), bflo(yv.y), bfhi(yv.y), bflo(yv.z), bfhi(yv.z), bflo(yv.w), bfhi(yv.w)};
            const float g[8] = {bflo(gv.x), bfhi(gv.x), bflo(gv.y), bfhi(gv.y), bflo(gv.z), bfhi(gv.z), bflo(gv.w), bfhi(gv.w)};
            float s = 0.f;
#pragma unroll
            for (int i = 0; i < 8; ++i) s += y[i];
            const float mu = wave_sum(s) * (1.0f / 512.0f); float q = 0.f;
#pragma unroll
            for (int i = 0; i < 8; ++i) { const float d = y[i] - mu; q += d * d; }
            const float rstd = 1.0f / sqrtf(wave_sum(q) * (1.0f / 512.0f) + HEAD_EPS);
            float o[8];
#pragma unroll
            for (int i = 0; i < 8; ++i) o[i] = (y[i] - mu) * rstd * silu_f(g[i]);
            v4u w; w.x = pk2(o[0], o[1]); w.y = pk2(o[2], o[3]); w.z = pk2(o[4], o[5]); w.w = pk2(o[6], o[7]); *gp = w; }
    }
}
DI void route_weights_to_lds(Frame& F, int layer) {
    const float* __restrict__ wg = F.ap->in[14] + (size_t)layer * DM * 4; const float* __restrict__ we2 = (const float*)(F.ws + WS_WE2) + (size_t)layer * DM * NEXP;
    LAS float* Lg = (LAS float*)(F.lds); LAS float* Le = (LAS float*)(F.lds + 16384);
    __syncthreads();
    { f32x4 vg[2], ve[16];
#pragma unroll
      for (int q = 0; q < 2; ++q) vg[q] = *(const f32x4*)(wg + (size_t)(F.tid + q * NTHR) * 4);
#pragma unroll
      for (int q = 0; q < 16; ++q) ve[q] = *(const f32x4*)(we2 + (size_t)(F.tid + q * NTHR) * 4);
#pragma unroll
      for (int q = 0; q < 2; ++q) { const int k = F.tid + q * NTHR, j = k >> 8, ln = (k & 255) >> 2, i = k & 3; *(LAS f32x4*)(Lg + ((j * 4 + i) * 64 + ln) * 4) = vg[q]; }
#pragma unroll
      for (int q = 0; q < 16; ++q) { const int p = F.tid + q * NTHR, half = p & 1, k = (p >> 1) & (DM - 1), g = p >> 11; const int j = k >> 8, ln = (k & 255) >> 2, i = k & 3;
          *(LAS f32x4*)(Le + ((((g * 4 + j) * 4 + i) * 2 + half) * 64 + ln) * 4) = ve[q]; } }
    if (F.tid < 4) ((LAS float*)(F.lds + 147456))[F.tid] = F.ap->in[15][layer * 4 + F.tid]; else if (F.tid < 4 + NEXP) ((LAS float*)(F.lds + 147456))[F.tid] = F.ap->in[17][layer * NEXP + F.tid - 4];
    __syncthreads();
}
DI int vw_first_row(int row0, int vl, int rpv, bool skip_ctx) { return skip_ctx ? (vl >> 3) * SL + CTX + (vl & 7) * rpv : row0 + vl * rpv; }
DI void e_route(Frame& F, int layer, int row0, int nvw, int vw_base, int rpv, bf16* H2, bool skip_ctx) {
    int* RT = (int*)(F.ws + WS_RT); int* CT = (int*)(F.ws + WS_CT);
    route_weights_to_lds(F, layer);
    constexpr int NR = 2;
    const int rpw = rpv / NWAVES;
    for (int vl = blockIdx.x; vl < nvw; vl += F.G) {
        int mt = F.tid; asm volatile("" : "+v"(mt));
        __syncthreads();
        if (mt < 32) F.MISC[mt] = 0u;
        __syncthreads();
        const int wb = vw_first_row(row0, vl, rpv, skip_ctx) + F.wave * rpw, we = wb + rpw;
        f32x4 xa[NR][4], xb[NR][4]; ModVec mv;
        auto issue = [&](int rb, f32x4 (&x)[NR][4]) { const float* __restrict__ xp = xs_row(F, rb);
#pragma unroll
            for (int k = 0; k < NR; ++k) ld_row(xp + (size_t)k * DM, F.lane, x[k]);
            __builtin_amdgcn_sched_barrier(0); };
        auto finish = [&](int rb, f32x4 (&x)[NR][4]) {
            f32x4 h[NR][4]; float rinv[NR]; rows_rinv<NR>(x, rinv);
#pragma unroll
            for (int k = 0; k < NR; ++k) { modulate_apply(x[k], rinv[k], mv, h[k]); st_row_bf16(H2 + (size_t)(rb + k) * DM, F.lane, h[k]); }
            int e0[NR], e1[NR]; float g0[NR], g1[NR]; route_rows<NR>(F, layer, h, F.lane, e0, e1, g0, g1);
            if (F.lane == 0) {
#pragma unroll
                for (int k = 0; k < NR; ++k) { const int r0 = (int)__hip_atomic_fetch_add((LAS unsigned*)(F.MISC + e0[k]), 1u, __ATOMIC_RELAXED, __HIP_MEMORY_SCOPE_WORKGROUP);
                    const int r1 = (int)__hip_atomic_fetch_add((LAS unsigned*)(F.MISC + e1[k]), 1u, __ATOMIC_RELAXED, __HIP_MEMORY_SCOPE_WORKGROUP);
                    int* rt = RT + (size_t)(rb + k) * 8; rt[0] = e0[k]; rt[1] = e1[k]; rt[2] = r0; rt[3] = r1; rt[4] = __builtin_bit_cast(int, g0[k]); rt[5] = __builtin_bit_cast(int, g1[k]); } } };
        for (int sb = wb; sb < we;) { const int se = seg_end(sb, we);
            if (skip_ctx && (sb % SL) < CTX) { sb = se; continue; }
            ld_modvec(mod_row(F, layer, sb), 3 * DM, F.lane, mv);
            int r = sb; issue(r, xa); __builtin_amdgcn_s_waitcnt(0x0F70);
            while (r + 2 * NR < se) { issue(r + NR, xb); finish(r, xa); issue(r + 2 * NR, xa); finish(r + NR, xb); r += 2 * NR; }
            if (r + NR < se) { issue(r + NR, xb); finish(r, xa); finish(r + NR, xb); } else finish(r, xa);
            sb = se; }
        __syncthreads();
        if (mt < 32) CT[(size_t)(vw_base + vl) * 32 + mt] = (int)F.MISC[mt];
    }
}
DI void moe_prep(Frame& F, int nvw_total, int nvw, int vw_base, int row0, int rpv, bool skip_ctx) {
    int* RT = (int*)(F.ws + WS_RT); const int* CT = (const int*)(F.ws + WS_CT); int* TILE = (int*)(F.ws + WS_TILE); int* SROW = (int*)(F.ws + WS_SROW); int* DROW = (int*)(F.ws + WS_DROW);
    const int dummy = skip_ctx ? 2 * NB * SEQ : 2 * MROWS;
    LAS int* sP = (LAS int*)(F.lds);
    LAS int* sBase = (LAS int*)(F.lds + 2048);
    LAS int* sOff = (LAS int*)(F.lds + 2304);
    LAS int* sTot = (LAS int*)(F.lds + 2560);
    __syncthreads();
    { const int e = F.tid & 31, grp = F.tid >> 5, per = nvw_total / 16; int s = 0; for (int v = grp * per; v < (grp + 1) * per; ++v) s += CT[(size_t)v * 32 + e]; sP[grp * 32 + e] = s; }
    __syncthreads();
    if (F.tid == 0) { int base = 0;
        for (int e = 0; e < 32; ++e) { int tot = 0; for (int g = 0; g < 16; ++g) tot += sP[g * 32 + e]; sBase[e] = base; sTot[e] = tot; const int nt = (tot + 255) >> 8;
            base += nt << 8; }
        sTot[32] = base >> 8;
        if (blockIdx.x == 0) TILE[0] = base >> 8; }
    __syncthreads();
    if (blockIdx.x == 0) for (int t = F.tid; t < sTot[32]; t += NTHR) { int e = 0;
#pragma unroll
        for (int q = 1; q < 32; ++q) if ((sBase[q] >> 8) <= t && sTot[q] > 0) e = q;
        TILE[1 + t] = e; }
    for (int e = blockIdx.x; e < 32; e += F.G) {
        const int lo = sBase[e] + sTot[e], hi = sBase[e] + (((sTot[e] + 255) >> 8) << 8);
        for (int s = lo + F.tid; s < hi; s += NTHR) { SROW[s] = 0; DROW[s] = dummy; } }
    for (int vl = blockIdx.x; vl < nvw; vl += F.G) { const int v = vw_base + vl;
        __syncthreads();
        if (F.tid < 32) { const int per = nvw_total / 16, g0 = v / per; int s = sBase[F.tid];
            for (int g = 0; g < g0; ++g) s += sP[g * 32 + F.tid];
            int c[32];
#pragma unroll
            for (int q = 0; q < 32; ++q) { const int vv = g0 * per + q; c[q] = (q < per && vv < v) ? CT[(size_t)vv * 32 + F.tid] : 0; }
#pragma unroll
            for (int q = 0; q < 32; ++q) s += c[q];
            sOff[F.tid] = s; }
        __syncthreads();
        for (int k = F.tid; k < rpv; k += NTHR) { const int r = vw_first_row(row0, vl, rpv, skip_ctx) + k; const int s = r % SL;
            if (skip_ctx && s < CTX) continue;
            int* rt = RT + (size_t)r * 8; const int e0 = rt[0], e1 = rt[1], s0 = sOff[e0] + rt[2], s1 = sOff[e1] + rt[3];
            const int ti = skip_ctx ? (r / SL) * SEQ + (s - CTX) : r;
            SROW[s0] = r; SROW[s1] = r; DROW[s0] = 2 * ti; DROW[s1] = 2 * ti + 1; }
    }
    __syncthreads();
}
DI void e_silu(Frame& F, const bf16* GU, bf16* HD) {
    const int gw = F.vcu * NWAVES + F.wave, NGW = F.G * NWAVES; const int nrows = ((const int*)(F.ws + WS_TILE))[0] * 256;
    for (int r = gw; r < nrows; r += NGW) { const v4u gv = *(const v4u*)(GU + (size_t)r * DM + 8 * F.lane), uv = *(const v4u*)(GU + (size_t)r * DM + 512 + 8 * F.lane);
        v4u w; w.x = pk2(silu_f(bflo(gv.x)) * bflo(uv.x), silu_f(bfhi(gv.x)) * bfhi(uv.x)); w.y = pk2(silu_f(bflo(gv.y)) * bflo(uv.y), silu_f(bfhi(gv.y)) * bfhi(uv.y));
        w.z = pk2(silu_f(bflo(gv.z)) * bflo(uv.z), silu_f(bfhi(gv.z)) * bfhi(uv.z)); w.w = pk2(silu_f(bflo(gv.w)) * bflo(uv.w), silu_f(bfhi(gv.w)) * bfhi(uv.w));
        *(v4u*)(HD + (size_t)r * EHID + 8 * F.lane) = w; }
}
template <int NR> DI void moe_combine_rows(const Frame& F, int layer, int r0, const bf16* __restrict__ YS, int lane, f32x4 (&x)[NR][4]) {
    const int* __restrict__ RT = (const int*)(F.ws + WS_RT); size_t s0[NR], s1[NR]; float g0[NR], g1[NR];
    const float* __restrict__ xp = xs_row(F, r0);
#pragma unroll
    for (int k = 0; k < NR; ++k) { const int* rt = RT + (size_t)(r0 + k) * 8; const int r = r0 + k; const size_t ti = layer ? (size_t)(r / SL) * SEQ + (r % SL - CTX) : (size_t)r;
        s0[k] = 2 * ti; s1[k] = 2 * ti + 1; g0[k] = __builtin_bit_cast(float, rt[4]); g1[k] = __builtin_bit_cast(float, rt[5]); ld_row(xp + (size_t)k * DM, lane, x[k]); }
    v2u a[NR][4], b[NR][4]; f32x4 g2[4]; const float* __restrict__ mod = mod_row(F, layer, r0);
#pragma unroll
    for (int j = 0; j < 4; ++j) g2[j] = *(const f32x4*)(mod + 5 * DM + 4 * lane + 256 * j);
#pragma unroll
    for (int k = 0; k < NR; ++k)
#pragma unroll
        for (int j = 0; j < 4; ++j) { a[k][j] = *(const v2u*)(YS + (size_t)s0[k] * DM + 4 * lane + 256 * j); b[k][j] = *(const v2u*)(YS + (size_t)s1[k] * DM + 4 * lane + 256 * j); }
#pragma unroll
    for (int k = 0; k < NR; ++k)
#pragma unroll
        for (int j = 0; j < 4; ++j) {
            const f32x4 av = (f32x4){bflo(a[k][j].x), bfhi(a[k][j].x), bflo(a[k][j].y), bfhi(a[k][j].y)}, bv = (f32x4){bflo(b[k][j].x), bfhi(b[k][j].x), bflo(b[k][j].y), bfhi(b[k][j].y)};
            x[k][j] = x[k][j] + g2[j] * (av * g0[k] + bv * g1[k]); }
}
template <bool SHADOW = false> DI void e3_combine0(Frame& F) {
    const int gw = F.vcu * NWAVES + F.wave, NGW = F.G * NWAVES; const bf16* __restrict__ YS = (const bf16*)(F.ws + WS_YS); bf16* __restrict__ H1 = (bf16*)(F.ws + WS_H1);
    constexpr int NR = 4;
    for (int r0 = gw * NR; r0 < MROWS; r0 += NGW * NR) { f32x4 x[NR][4]; ModVec mv; ld_modvec(mod_row(F, 1, r0), 0, F.lane, mv); moe_combine_rows<NR>(F, 0, r0, YS, F.lane, x);
        float* __restrict__ xp = xs_row(F, r0); float rinv[NR]; rows_rinv<NR>(x, rinv);
#pragma unroll
        for (int k = 0; k < NR; ++k) { f32x4 h[4]; if (!SHADOW) st_row(xp + (size_t)k * DM, F.lane, x[k]); modulate_apply(x[k], rinv[k], mv, h); st_row_bf16(H1 + (size_t)(r0 + k) * DM, F.lane, h); } }
}
DI void e4_qknorm(Frame& F) {
    const int gw = F.vcu * NWAVES + F.wave, NGW = F.G * NWAVES; bf16* Q = (bf16*)(F.ws + WS_QKV1); const f32x2* TA = (const f32x2*)(F.ws + WS_TA);
    const int lane = F.lane, j0 = 2 * (lane & 15); const bool second = (lane & 16) != 0, axis1 = lane >= 32;
    const f32x2 kg = *(const f32x2*)(F.ap->in[13] + 2 * lane);
    constexpr int NR = 4;
    for (int r0 = gw * NR; r0 < MROWS; r0 += NGW * NR) {
        const int s0 = r0 % SL; const bool ctx = s0 < CTX; const float sg = second ? 1.0f : -1.0f;
        unsigned o[2 * NR]; float ss[2 * NR];
#pragma unroll
        for (int k = 0; k < NR; ++k)
#pragma unroll
            for (int hh = 0; hh < 2; ++hh) { o[2 * k + hh] = *(const unsigned*)(Q + (size_t)(r0 + k) * ATT_IN + (8 + hh) * 128 + 2 * lane); ss[2 * k + hh] = bflo(o[2 * k + hh]) * bflo(o[2 * k + hh]) + bfhi(o[2 * k + hh]) * bfhi(o[2 * k + hh]); }
        wave_sum_n<2 * NR>(ss);
        float x0[2 * NR], x1[2 * NR];
#pragma unroll
        for (int i = 0; i < 2 * NR; ++i) { const float rinv = 1.0f / sqrtf(ss[i] * (1.0f / 128.0f) + NORM_EPS); x0[i] = bflo(o[i]) * rinv * kg[0]; x1[i] = bfhi(o[i]) * rinv * kg[1]; }
        if (!ctx) {
#pragma unroll
            for (int k = 0; k < NR; ++k) { const int t = s0 + k - CTX, pos = axis1 ? (t & 63) : (t >> 6); const f32x4 cs = *(const f32x4*)(TA + pos * 32 + j0);
#pragma unroll
                for (int hh = 0; hh < 2; ++hh) { const int i = 2 * k + hh; const float y0 = __shfl_xor(x0[i], 16), y1 = __shfl_xor(x1[i], 16);
                    x0[i] = x0[i] * cs[0] + sg * y0 * cs[1]; x1[i] = x1[i] * cs[2] + sg * y1 * cs[3]; } } }
#pragma unroll
        for (int k = 0; k < NR; ++k)
#pragma unroll
            for (int hh = 0; hh < 2; ++hh) *(unsigned*)(Q + (size_t)(r0 + k) * ATT_IN + (8 + hh) * 128 + 2 * lane) = pk2(x0[2 * k + hh], x1[2 * k + hh]);
    }
}
DI void att_phase(Frame& F) {
    const bf16* QKV = (const bf16*)(F.ws + WS_QKV1); bf16* AO = (bf16*)(F.ws + WS_AO);
    for (int u = F.vcu; u < NB * 8 * 8; u += F.G) { const int qb = u & 7, hq = (u >> 3) & 7, b = u >> 6, kvh = hq >> 2;
        const size_t qrow = (size_t)b * SL + CTX + 256 * qb, krow = (size_t)b * SL;
        att::attn_dense_body<att::bf16>(QKV + qrow * ATT_IN + hq * 128, QKV + krow * ATT_IN + 1024 + kvh * 128, QKV + krow * ATT_IN + 1280 + kvh * 128, AO + qrow * DM + hq * 128, SL, (char*)F.lds);
        __syncthreads(); }
}
template <bool SHADOW = false> DI void e6_final(Frame& F) {
    const int gw = F.vcu * NWAVES + F.wave, NGW = F.G * NWAVES; const bf16* __restrict__ YS = (const bf16*)(F.ws + WS_YS1);
    constexpr int NR = 4;
    for (int r0 = gw * NR; r0 < MROWS; r0 += NGW * NR) { if (r0 % SL < CTX) continue;
        f32x4 x[NR][4], fg[4];
#pragma unroll
        for (int j = 0; j < 4; ++j) fg[j] = *(const f32x4*)(F.ap->in[21] + 4 * F.lane + 256 * j);
        moe_combine_rows<NR>(F, 1, r0, YS, F.lane, x);
        float* __restrict__ xp = xs_row(F, r0); float rinv[NR]; rows_rinv<NR>(x, rinv);
#pragma unroll
        for (int k = 0; k < NR; ++k) {
#pragma unroll
            for (int j = 0; j < 4; ++j) x[k][j] = x[k][j] * rinv[k] * fg[j];
            if (!SHADOW) st_row(xp + (size_t)k * DM, F.lane, x[k]); else if (x[k][0][0] == 123456.789f) st_row(xp + (size_t)k * DM, F.lane, x[k]); } }
}
#ifndef DUP_E3
#define DUP_E3 0
#endif
#ifndef DUP_E6
#define DUP_E6 0
#endif
#ifndef DUP_BAR
#define DUP_BAR 0
#endif
#ifndef DUP_P0
#define DUP_P0 0
#endif
#ifndef DUP_E1
#define DUP_E1 0
#endif
#ifndef DUP_RT
#define DUP_RT 0
#endif
#ifndef DUP_PREP
#define DUP_PREP 0
#endif
#ifndef DUP_RET
#define DUP_RET 0
#endif
#ifndef DUP_ATT
#define DUP_ATT 0
#endif
#ifndef DUP_G1
#define DUP_G1 0
#endif
#ifndef DUP_GG
#define DUP_GG 0
#endif
#ifndef DUP_GO
#define DUP_GO 0
#endif
#ifndef DUP_MG1
#define DUP_MG1 0
#endif
#ifndef DUP_MG2
#define DUP_MG2 0
#endif
#ifndef DUP_GQ
#define DUP_GQ 0
#endif
#ifndef DUP_GA
#define DUP_GA 0
#endif
#ifndef EN_P0
#define EN_P0 1
#endif
#ifndef EN_P0B
#define EN_P0B 1
#endif
#ifndef EN_E1
#define EN_E1 1
#endif
#ifndef EN_G1
#define EN_G1 1
#endif
#ifndef EN_ROPE
#define EN_ROPE 1
#endif
#ifndef EN_RET
#define EN_RET 1
#endif
#ifndef EN_GG
#define EN_GG 1
#endif
#ifndef EN_HN
#define EN_HN 1
#endif
#ifndef EN_GO
#define EN_GO 1
#endif
#ifndef EN_E2
#define EN_E2 1
#endif
#ifndef EN_PREP
#define EN_PREP 1
#endif
#ifndef EN_MG1
#define EN_MG1 1
#endif
#ifndef EN_SILU
#define EN_SILU 1
#endif
#ifndef EN_MG2
#define EN_MG2 1
#endif
#ifndef EN_E3
#define EN_E3 1
#endif
#ifndef EN_GQ
#define EN_GQ 1
#endif
#ifndef EN_E4
#define EN_E4 1
#endif
#ifndef EN_ATT
#define EN_ATT 1
#endif
#ifndef EN_GA
#define EN_GA 1
#endif
#ifndef EN_E5
#define EN_E5 1
#endif
#ifndef EN_E6
#define EN_E6 1
#endif
#ifndef MK_PER_PHASE
#define MK_PER_PHASE 0
#endif
constexpr int NPH = 25;

#define MOE_BLOCK(layer_, pb_, NVT_, RPV_, H2_, AS_, HD_, YS_, SKIP_) \
    if (EN_PREP && IN((pb_) + 0)) { moe_prep(F, NVT_, NVT_, 0, 0, RPV_, SKIP_); if (BOTH((pb_) + 0)) GRID_BAR(); } \
    if (EN_MG1 && IN((pb_) + 1)) { pg8::Gemm g{(const bf16*)(ws + (H2_)), (const bf16*)(ws + WS_WGU) + (size_t)(layer_) * 32 * 1024 * 1024, MAXSLOTS, 1024, 1024, (const int*)(ws + WS_SROW)}; pg8::GroupedOrder S; S.init((const int*)(ws + WS_TILE), F.G, F.vcu); \
        pg8::EpiSwiGLU E{(bf16*)(ws + (HD_)), 512, 3}; pg8::gemm_phase<pg8::EpiSwiGLU, pg8::GroupedOrder, true, true, true>(F.lds, g, S, E); if (DUP_MG1) { pg8::gemm_phase<pg8::EpiSwiGLU, pg8::GroupedOrder, true, true, true>(F.lds, g, S, E); } if (BOTH((pb_) + 1)) GRID_BAR(); } \
    if (EN_MG2 && IN((pb_) + 3)) { pg8::Gemm g{(const bf16*)(ws + (HD_)), (const bf16*)(ws + WS_WD) + (size_t)(layer_) * 32 * 1024 * 512, MAXSLOTS, 1024, 512}; pg8::GroupedOrder S; S.init((const int*)(ws + WS_TILE), F.G, F.vcu); \
        pg8::EpiScatterBf16 E{(bf16*)(ws + (YS_)), (const int*)(ws + WS_DROW), 3}; pg8::gemm_phase<pg8::EpiScatterBf16, pg8::GroupedOrder, true, true>(F.lds, g, S, E); if (DUP_MG2) { pg8::gemm_phase<pg8::EpiScatterBf16, pg8::GroupedOrder, true, true>(F.lds, g, S, E); } if (BOTH((pb_) + 3)) GRID_BAR(); }

#define LAYER0_QKV_RET(hb, pb) \
        if (EN_G1 && IN(pb + 0)) { \
            pg8::Gemm g{(const bf16*)(ws + WS_H0) + (size_t)(hb) * HROWS * DM, (const bf16*)(ws + WS_WIN), HROWS, RET_QKV, DM}; pg8::StaticOrder S; S.init(HROWS, RET_QKV, F.G, (int)blockIdx.x); \
            pg8::EpiRopeQKV E{(bf16*)(ws + WS_QKV0), (const float*)(ws + WS_TR), hb * 144}; pg8::gemm_phase<pg8::EpiRopeQKV, pg8::StaticOrder, true, true>(F.lds, g, S, E); if (DUP_G1) { pg8::gemm_phase<pg8::EpiRopeQKV, pg8::StaticOrder, true, true>(F.lds, g, S, E); } \
            if (hb == 0) p0_background(F, S.nwg, BG3_LO, BG3_LO + BG3); else p0_background(F, S.nwg, BG5_LO, BG5_LO + BG5); \
            if (BOTH(pb + 0)) GRID_BAR(); } \
        if (EN_RET && IN(pb + 1)) { ret_phase(F, hb); if (BOTH(pb + 1)) GRID_BAR(); }
__global__ void __launch_bounds__(NTHR, 2) mk_fwd(Args args) {
    extern __shared__ __attribute__((aligned(16))) unsigned char lds_raw[];
    Frame F;
    F.lds = (LAS unsigned char*)lds_raw;
    F.MISC = (volatile LAS unsigned*)(F.lds + MISC_OFF);
    F.tid = threadIdx.x; F.lane = F.tid & 63; F.wave = __builtin_amdgcn_readfirstlane(F.tid >> 6);
    F.G = gridDim.x; { const int bx = blockIdx.x; F.vcu = (F.G % 8 == 0) ? (bx % 8) * (F.G / 8) + bx / 8 : bx; }
    unsigned char* ws = args.ws; F.ws = ws; F.out = args.out;
    F.ap = (const CAS Args*)__builtin_amdgcn_kernarg_segment_ptr();
    F.ctl = (gu32*)(ws + WS_CTL);
    for (int u = F.tid; u < (LDS_BYTES - MISC_OFF) / 4; u += NTHR) ((LAS unsigned*)(F.lds + MISC_OFF))[u] = 0u;
    __syncthreads();
    const int lo = args.ph_lo, hi = args.ph_hi;
    XcdBarrier bar; bar.bar = (unsigned*)(F.ctl + CW_BAR) + args.li * BAR_STRIDE; bar.x = 0; bar.st = nullptr;
    if (hi - lo > 1) bar = xcd_barrier_post((unsigned*)(F.ctl + CW_BAR) + args.li * BAR_STRIDE, F.MISC + 64);
#define GRID_BAR() xcd_barrier(bar)
#define IN(k) (lo <= (k) && (k) < hi)
#define BOTH(k) (IN(k) && IN((k) + 1))

    if (EN_P0 && IN(0)) { p0_prologue(F); if (DUP_P0) p0_prologue(F); if (BOTH(0)) GRID_BAR(); }
    if (EN_P0B && IN(1)) { p0b_modreduce(F); if (BOTH(1)) GRID_BAR(); }

    if (EN_E1 && IN(2)) { e1_modulate0(F); if (BOTH(2)) GRID_BAR(); }
    LAYER0_QKV_RET(0, 3)
    LAYER0_QKV_RET(1, 5)
    if (EN_GG && IN(7)) {
        pg8::Gemm g{(const bf16*)(ws + WS_H0), (const bf16*)(ws + WS_WIN) + (size_t)RET_QKV * DM, MROWS, RET_V, DM}; pg8::StaticOrder S; S.init(MROWS, RET_V, F.G, (int)blockIdx.x);
        pg8::EpiHeadGate E{(const bf16*)(ws + WS_Y0), (const float*)(ws + WS_PS), (bf16*)(ws + WS_A2)}; pg8::gemm_phase<pg8::EpiHeadGate, pg8::StaticOrder, true, true>(F.lds, g, S, E); if (DUP_GG) { pg8::gemm_phase<pg8::EpiHeadGate, pg8::StaticOrder, true, true>(F.lds, g, S, E); }
        p0_background(F, S.nwg, BG7_LO, BG7_LO + BG7);
        if (BOTH(7)) GRID_BAR(); }
    if (EN_GO && IN(8)) {
        pg8::Gemm g{(const bf16*)(ws + WS_A2), (const bf16*)(ws + WS_WOUT), MROWS, DM, RET_V}; pg8::StaticOrder S; S.init(MROWS, DM, F.G, (int)blockIdx.x);
        pg8::EpiResid E{F.ap->in[0], F.ap->in[2], F.out, (float*)(ws + WS_XC), (const float*)(ws + WS_MOD), 2 * DM, 0}; pg8::gemm_phase<pg8::EpiResid, pg8::StaticOrder, true, true>(F.lds, g, S, E); if (DUP_GO) { pg8::gemm_phase<pg8::EpiResid, pg8::StaticOrder, true, true>(F.lds, g, S, E); }
        p0_background(F, S.nwg, BG8_LO, BG8_LO + BG8);
        if (BOTH(8)) GRID_BAR(); }
    if (EN_E2 && IN(9)) { e_route(F, 0, 0, 512, 0, 144, (bf16*)(ws + WS_H2_0), false); if (DUP_RT) e_route(F, 0, 0, 512, 0, 144, (bf16*)(ws + WS_H2_0), false); if (BOTH(9)) GRID_BAR(); }
    MOE_BLOCK(0, 10, 512, 144, WS_H2_0, WS_AS, WS_HD, WS_YS, false)
    if (EN_E3 && IN(14)) { if (DUP_E3) e3_combine0<true>(F); e3_combine0(F); if (BOTH(14)) GRID_BAR(); }

    if (EN_GQ && IN(15)) {
        pg8::Gemm g{(const bf16*)(ws + WS_H1), (const bf16*)(ws + WS_WQKV), MROWS, ATT_IN, DM}; pg8::StaticOrder S; S.init(MROWS, ATT_IN, F.G, (int)blockIdx.x);
        pg8::EpiQKNorm E{(bf16*)(ws + WS_QKV1), (const float*)(ws + WS_TA), (const float*)(ws + WS_QKG), (const float*)(ws + WS_QKG) + 128, (PG8_LAS float*)(F.lds + 131072)}; pg8::gemm_phase<pg8::EpiQKNorm, pg8::StaticOrder, true, true>(F.lds, g, S, E);
        p0_background(F, S.nwg, BG15_LO, BG15_LO + BG15);
        if (BOTH(15)) GRID_BAR(); }
    if (EN_ATT && IN(17)) { att_phase(F); if (BOTH(17)) GRID_BAR(); }
    if (EN_GA && IN(18)) {
        pg8::Gemm g{(const bf16*)(ws + WS_AO), (const bf16*)(ws + WS_WO), MROWS, DM, DM}; pg8::LatentOrder S; S.init(F.G, F.vcu);
        pg8::EpiResid E{F.out, (const float*)(ws + WS_XC), F.out, (float*)(ws + WS_XC), (const float*)(ws + WS_MOD) + (size_t)33 * NMOD, 2 * DM, 0}; pg8::gemm_phase<pg8::EpiResid, pg8::LatentOrder, true, true>(F.lds, g, S, E);
        if (BOTH(18)) GRID_BAR(); }
    if (EN_E5 && IN(19)) { e_route(F, 1, 0, 256, 0, 256, (bf16*)(ws + WS_H2_1), true); if (BOTH(19)) GRID_BAR(); }
    MOE_BLOCK(1, 20, 256, 256, WS_H2_1, WS_AS1, WS_HD1, WS_YS1, true)
    if (DUP_BAR && hi - lo > 1) { for (int i = 0; i < 20 * DUP_BAR; ++i) GRID_BAR(); }
    if (EN_E6 && IN(24)) { if (DUP_E6) e6_final<true>(F); e6_final(F); }
#undef IN
#undef BOTH
#undef GRID_BAR
}

extern "C" void kernel_launch(void* const* d_in, const int* in_sizes, int n_in, void* d_out, int out_size, void* d_ws, size_t ws_size, hipStream_t stream) {
    static int grid = 0;
    if (grid == 0) {
        if (n_in != 22 || out_size != NB * SEQ * DM || ws_size < WS_END) { fprintf(stderr, "kernel_launch: unexpected shapes: n_in %d out %d ws %zu (need %zu)\n", n_in, out_size, ws_size, (size_t)WS_END); grid = -1; return; }
        int dev = 0, cus = 0, per_cu = 0;
        if (hipGetDevice(&dev) != hipSuccess || hipDeviceGetAttribute(&cus, hipDeviceAttributeMultiprocessorCount, dev) != hipSuccess) { grid = -1; return; }
        if (hipFuncSetAttribute((const void*)mk_fwd, hipFuncAttributeMaxDynamicSharedMemorySize, LDS_BYTES) != hipSuccess) { fprintf(stderr, "kernel_launch: hipFuncSetAttribute failed\n"); grid = -1; return; }
        if (hipOccupancyMaxActiveBlocksPerMultiprocessor(&per_cu, (const void*)mk_fwd, NTHR, LDS_BYTES) != hipSuccess || per_cu < 1) fprintf(stderr, "kernel_launch: occupancy query reports %d\n", per_cu);
        (void)hipGetLastError();
        grid = cus;
        if (grid != 256) fprintf(stderr, "kernel_launch: %d CUs (built for 256)\n", grid);
    }
    if (grid < 0) return;
    if (hipMemsetAsync((char*)d_ws + WS_CTL, 0, CTL_ZERO_BYTES, stream) != hipSuccess) return;
    Args a{};
    for (int i = 0; i < 22; ++i) a.in[i] = (const float*)d_in[i];
    a.out = (float*)d_out; a.ws = (unsigned char*)d_ws; a.pad = 0;
#if defined(REPLAY_HI)
    a.ph_lo = 0; a.ph_hi = REPLAY_HI; a.li = 0; hipLaunchKernelGGL(mk_fwd, dim3(grid), dim3(NTHR), LDS_BYTES, stream, a);
    a.ph_lo = 0; a.ph_hi = NPH; a.li = 1; hipLaunchKernelGGL(mk_fwd, dim3(grid), dim3(NTHR), LDS_BYTES, stream, a);
#elif MK_PER_PHASE
    for (int ph = 0; ph < NPH; ++ph) { a.ph_lo = ph; a.ph_hi = ph + 1; a.li = 0; hipLaunchKernelGGL(mk_fwd, dim3(grid), dim3(NTHR), LDS_BYTES, stream, a); }
#else
    a.ph_lo = 0; a.ph_hi = NPH; a.li = 0; hipLaunchKernelGGL(mk_fwd, dim3(grid), dim3(NTHR), LDS_BYTES, stream, a);
#endif
    const hipError_t le = hipPeekAtLastError();
    if (le != hipSuccess) fprintf(stderr, "kernel_launch: launch failed: %s\n", hipGetErrorName(le));
}
```

```cpp
#include <hip/hip_runtime.h>
#include <cstdio>
#include <cstdint>
#define MK_PER_PHASE 0
#ifndef PROBE_PHASE
#define PROBE_PHASE (-1)
#endif
#ifndef PROBE_KIND
#define PROBE_KIND 0
#endif
#ifndef PROBE_AMP
#define PROBE_AMP 4
#endif
#define PRB_W(lds_) ((volatile __attribute__((address_space(3))) unsigned*)(unsigned)(155648 + 400))
__device__ __forceinline__ void prb_begin(__attribute__((address_space(3))) unsigned char* lds, int kind) {
    if (PROBE_PHASE >= 0 && PROBE_KIND == kind && blockIdx.x == 0 && threadIdx.x == 0) { volatile __attribute__((address_space(3))) unsigned* w = PRB_W(lds); if (w[0]) w[3] = (unsigned)__builtin_amdgcn_s_memrealtime(); } }
__device__ __forceinline__ void prb_end(__attribute__((address_space(3))) unsigned char* lds, int kind) {
    if (PROBE_PHASE >= 0 && PROBE_KIND == kind && blockIdx.x == 0 && threadIdx.x == 0) { volatile __attribute__((address_space(3))) unsigned* w = PRB_W(lds); if (w[0]) w[2] += (unsigned)__builtin_amdgcn_s_memrealtime() - w[3]; } }
namespace pg8 {
#define PG8_LAS __attribute__((address_space(3)))
typedef unsigned short bf16_t;
typedef short bf16x8 __attribute__((ext_vector_type(8)));
typedef float f32x4 __attribute__((ext_vector_type(4)));
typedef unsigned u32x4 __attribute__((ext_vector_type(4)));
constexpr int BM = 256, BK = 64, HALF = 128, HTB = HALF * BK * 2  , STAGE_BYTES = 8 * HTB, NXCD = 8, WGM = 8;

__host__ __device__ __forceinline__ int lds_byte(int r, int c) { const int st = (r >> 4) * 2 + (c >> 5), rr = r & 15, cc = c & 31, ob = rr * 64 + cc * 2; return st * 1024 + (ob ^ (((ob >> 9) & 1) << 5)); }
__host__ __device__ __forceinline__ void stage_rc(int b, int& R, int& C) { const int st = b / 1024, sb = b % 1024, swz = sb ^ (((sb >> 9) & 1) << 5); R = (st >> 1) * 16 + swz / 64; C = (st & 1) * 32 + (swz % 64) / 2; }
__host__ __device__ __forceinline__ int perm32(int rho) { const int n = rho >> 4, i = rho & 15; return 8 * (i >> 2) + 4 * n + (i & 3); }

struct Unit { int pm, pn; };
struct Gemm { const bf16_t* A; const bf16_t* Bt; int M, N, K; const int* rowidx = nullptr; };

struct StaticOrder {
    int nM, nN, nwg, G, c;
    __host__ __device__ void init(int M, int N, int G_, int c_) { nM = M / BM; nN = N / BM; nwg = nM * nN; G = G_; c = c_; }
    __host__ __device__ bool next(int i, Unit& u) const {
        const long L = (long)i * G + c; if (L >= nwg) return false;
        int wgid = (int)L; { const int q = nwg / NXCD, r = nwg % NXCD, xcd = wgid % NXCD, off = wgid / NXCD; wgid = (xcd < r ? xcd * (q + 1) : r * (q + 1) + (xcd - r) * q) + off; }
        const int nig = WGM * nN, gid = wgid / nig, fm = gid * WGM, gsz = (nM - fm) < WGM ? (nM - fm) : WGM;
        u.pm = fm + ((wgid % nig) % gsz); u.pn = (wgid % nig) / gsz; return true;
    }
    __device__ __forceinline__ void a_ready(const Unit&) const {}
    __device__ __forceinline__ void done(const Unit&) const {}
};

__device__ __forceinline__ unsigned cvt_pk_bf16(float lo, float hi) { unsigned r; asm volatile("v_cvt_pk_bf16_f32 %0, %1, %2" : "=v"(r) : "v"(lo), "v"(hi)); return r; }
typedef float f32x2 __attribute__((ext_vector_type(2)));
__device__ __forceinline__ f32x2 gelu_pk(f32x2 v) {
    const f32x2 av = __builtin_elementwise_abs(v), d = av * 0.2316418882f + 1.0f;
    f32x2 t; t.x = __builtin_amdgcn_rcpf(d.x); t.y = __builtin_amdgcn_rcpf(d.y);
    f32x2 q = t * 0.5307027145f + (-0.7265760135f); q = q * t + 0.7107068705f; q = q * t + (-0.142248368f); q = q * t + 0.127414796f; q = q * t;
    const f32x2 s = (v * v) * (-0.72134752044f);
    f32x2 e; e.x = __builtin_amdgcn_exp2f(s.x); e.y = __builtin_amdgcn_exp2f(s.y);
    const f32x2 m = v * (q * e), r = v - m;
    f32x2 o; o.x = v.x < 0.f ? m.x : r.x; o.y = v.y < 0.f ? m.y : r.y; return o;
}

template <int ACT  > struct EpiBf16 {
    static constexpr bool PERM = true, AFTER_DRAIN = false; static_assert(ACT == 0 || ACT == 1, "EpiBf16: ACT is 0 (none) or 1 (gelu_pk)");
    bf16_t* O; int ldc; const float* bias; int split_cols; size_t split_stride; float scale0;
    __device__ __forceinline__ void operator()(const f32x4 (&acc)[2][2][4][2], const Unit& u, int wr, int wc, int fr, int fq) const {
        const int row0 = u.pm * BM + wr * 64 + fr; int colt = u.pn * BM; bf16_t* base = O;
        float sc = 1.f; if (split_cols) { const int t = colt / split_cols; base += (size_t)t * split_stride; colt -= t * split_cols; if (t == 0) sc = scale0; }
        const int col0 = colt + wc * 32 + 8 * fq, bcol0 = u.pn * BM + wc * 32 + 8 * fq;
        f32x4 bv[2][2];
#pragma unroll
        for (int bj = 0; bj < 2; ++bj)
#pragma unroll
            for (int n = 0; n < 2; ++n) bv[bj][n] = bias ? *(const f32x4*)(bias + bcol0 + bj * HALF + 4 * n) : (f32x4){0.f, 0.f, 0.f, 0.f};
#pragma unroll
        for (int ai = 0; ai < 2; ++ai)
#pragma unroll
            for (int m = 0; m < 4; ++m) { bf16_t* rowp = base + (size_t)(row0 + ai * HALF + m * 16) * ldc + col0;
#pragma unroll
                for (int bj = 0; bj < 2; ++bj) { f32x4 v0 = acc[ai][bj][m][0] + bv[bj][0], v1 = acc[ai][bj][m][1] + bv[bj][1];
                    if (ACT == 1) { f32x2 a = gelu_pk((f32x2){v0[0], v0[1]}), b = gelu_pk((f32x2){v0[2], v0[3]}), c = gelu_pk((f32x2){v1[0], v1[1]}), d = gelu_pk((f32x2){v1[2], v1[3]});
                        v0 = (f32x4){a.x, a.y, b.x, b.y}; v1 = (f32x4){c.x, c.y, d.x, d.y}; }
                    v0 = v0 * sc; v1 = v1 * sc; u32x4 w; w.x = cvt_pk_bf16(v0[0], v0[1]); w.y = cvt_pk_bf16(v0[2], v0[3]); w.z = cvt_pk_bf16(v1[0], v1[1]); w.w = cvt_pk_bf16(v1[2], v1[3]);
                    *(u32x4*)(rowp + bj * HALF) = w; } }
    }
};
struct EpiStoreBf16 {
    static constexpr bool PERM = true, AFTER_DRAIN = false;
    bf16_t* O; int ldc; int pnmask;
    __device__ __forceinline__ void operator()(const f32x4 (&acc)[2][2][4][2], const Unit& u, int wr, int wc, int fr, int fq) const {
        const int row0 = u.pm * BM + wr * 64 + fr, col0 = (u.pn & pnmask) * BM + wc * 32 + 8 * fq;
#pragma unroll
        for (int ai = 0; ai < 2; ++ai)
#pragma unroll
            for (int m = 0; m < 4; ++m) { bf16_t* rowp = O + (size_t)(row0 + ai * HALF + m * 16) * ldc + col0;
#pragma unroll
                for (int bj = 0; bj < 2; ++bj) { const f32x4 v0 = acc[ai][bj][m][0], v1 = acc[ai][bj][m][1];
                    u32x4 w; w.x = cvt_pk_bf16(v0[0], v0[1]); w.y = cvt_pk_bf16(v0[2], v0[3]); w.z = cvt_pk_bf16(v1[0], v1[1]); w.w = cvt_pk_bf16(v1[2], v1[3]);
                    *(u32x4*)(rowp + bj * HALF) = w; } }
    }
};
struct EpiStoreF32 {
    static constexpr bool PERM = false, AFTER_DRAIN = false;
    float* C; int ldc; int pnmask;
    __device__ __forceinline__ void operator()(const f32x4 (&acc)[2][2][4][2], const Unit& u, int wr, int wc, int fr, int fq) const {
        const int row0 = u.pm * BM + wr * 64 + fr, col0 = (u.pn & pnmask) * BM + wc * 32 + 4 * fq;
#pragma unroll
        for (int ai = 0; ai < 2; ++ai)
#pragma unroll
            for (int m = 0; m < 4; ++m) { float* rowp = C + (size_t)(row0 + ai * HALF + m * 16) * ldc + col0;
#pragma unroll
                for (int bj = 0; bj < 2; ++bj)
#pragma unroll
                    for (int n = 0; n < 2; ++n) *(f32x4*)(rowp + bj * HALF + n * 16) = acc[ai][bj][m][n]; }
    }
};
struct GroupedOrder {
    const int* tile_e; int n_units, G, c;
    __device__ __forceinline__ void init(const int* tile_tab, int G_, int c_) { n_units = tile_tab[0] * 4; tile_e = tile_tab + 1; G = G_; c = c_; }
    __device__ __forceinline__ bool next(int i, Unit& u) const {
        const long L = (long)i * G + c; if (L >= n_units) return false;
        const int pm = (int)(L >> 2); u.pm = pm; u.pn = tile_e[pm] * 4 + (int)(L & 3); return true;
    }
    __device__ __forceinline__ void a_ready(const Unit&) const {}
    __device__ __forceinline__ void done(const Unit&) const {}
};

struct EpiSwiGLU {
    static constexpr bool PERM = true, AFTER_DRAIN = false;
    bf16_t* O; int ldc; int pnmask;
    __device__ __forceinline__ void operator()(const f32x4 (&acc)[2][2][4][2], const Unit& u, int wr, int wc, int fr, int fq) const {
        const int row0 = u.pm * BM + wr * 64 + fr, col0 = (u.pn & pnmask) * 128 + wc * 16 + 4 * fq;
#pragma unroll
        for (int ai = 0; ai < 2; ++ai)
#pragma unroll
            for (int m = 0; m < 4; ++m) { bf16_t* rowp = O + (size_t)(row0 + ai * HALF + m * 16) * ldc + col0;
#pragma unroll
                for (int bj = 0; bj < 2; ++bj) { const f32x4 g = acc[ai][bj][m][0], up = acc[ai][bj][m][1];
                    typedef float f32x2_t __attribute__((ext_vector_type(2)));
                    const f32x2_t one2 = (f32x2_t){1.0f, 1.0f}, nl2 = (f32x2_t){-1.4426950408889634f, -1.4426950408889634f}; f32x2_t h2[2];
#pragma unroll
                    for (int p = 0; p < 2; ++p) { const f32x2_t g2 = (f32x2_t){g[2 * p], g[2 * p + 1]}, u2 = (f32x2_t){up[2 * p], up[2 * p + 1]}, t2 = g2 * nl2;
                        const f32x2_t d2 = (f32x2_t){__builtin_amdgcn_exp2f(t2[0]), __builtin_amdgcn_exp2f(t2[1])} + one2;
                        const f32x2_t r2 = (f32x2_t){__builtin_amdgcn_rcpf(d2[0]), __builtin_amdgcn_rcpf(d2[1])};
                        h2[p] = (g2 * r2) * u2; }
                    typedef unsigned u32x2_t __attribute__((ext_vector_type(2))); u32x2_t w; w.x = cvt_pk_bf16(h2[0][0], h2[0][1]); w.y = cvt_pk_bf16(h2[1][0], h2[1][1]);
                    *(u32x2_t*)(rowp + bj * 64) = w; } }
    }
};
template <bool PUB = false> struct EpiResidT {
    static constexpr bool PERM = false, AFTER_DRAIN = false;
    const float* s_lat; const float* s_ctx; float* d_lat; float* d_ctx; const float* mod; int gate_off; int tile0;
    __device__ __forceinline__ void operator()(const f32x4 (&acc)[2][2][4][2], const Unit& u, int wr, int wc, int fr, int fq) const {
        const int tile = tile0 + u.pm, b = tile / 9, st = tile - 9 * b;
        const size_t rbase = st == 0 ? (size_t)b * 256 : (size_t)b * 2048 + (size_t)(st - 1) * 256;
        const float* src = (st == 0 ? s_ctx : s_lat) + rbase * 1024; float* dst = (st == 0 ? d_ctx : d_lat) + rbase * 1024;
        const float* gp = mod + (size_t)(st == 0 ? 32 : b) * 6144 + gate_off;
        const int r0 = wr * 64 + fr, col0 = u.pn * BM + wc * 32 + 4 * fq;
        f32x4 gv[2][2];
#pragma unroll
        for (int bj = 0; bj < 2; ++bj)
#pragma unroll
            for (int n = 0; n < 2; ++n) gv[bj][n] = *(const f32x4*)(gp + col0 + bj * HALF + n * 16);
        struct Qx { f32x4 xv[2][2][2]; };
        auto issue = [&](int ai, int mh, Qx& q) {
#pragma unroll
            for (int mm = 0; mm < 2; ++mm) { const size_t off = (size_t)(r0 + ai * HALF + (2 * mh + mm) * 16) * 1024 + col0;
#pragma unroll
                for (int bj = 0; bj < 2; ++bj)
#pragma unroll
                    for (int n = 0; n < 2; ++n) q.xv[mm][bj][n] = *(const f32x4*)(src + off + bj * HALF + n * 16); } };
        auto finish = [&](int ai, int mh, const Qx& q, const f32x4 (&a4)[2][2][4][2]) {
#pragma unroll
            for (int mm = 0; mm < 2; ++mm) { const int m = 2 * mh + mm; const size_t off = (size_t)(r0 + ai * HALF + m * 16) * 1024 + col0;
#pragma unroll
                for (int bj = 0; bj < 2; ++bj)
#pragma unroll
                    for (int n = 0; n < 2; ++n) { const f32x4 ov = q.xv[mm][bj][n] + gv[bj][n] * a4[ai][bj][m][n]; float* dp = dst + off + bj * HALF + n * 16;
                        if constexpr (PUB) asm volatile("global_store_dwordx4 %0, %1, off sc1" :: "v"(dp), "v"(ov) : "memory"); else *(f32x4*)dp = ov; } } };
        Qx qa, qb;
        issue(0, 0, qa); issue(0, 1, qb); finish(0, 0, qa, acc); issue(1, 0, qa); finish(0, 1, qb, acc); issue(1, 1, qb); finish(1, 0, qa, acc); finish(1, 1, qb, acc);
    }
};
typedef EpiResidT<false> EpiResid;
template <int MODE> struct PanelOrder {
    int G, c; unsigned* cnt;
    static __device__ __forceinline__ int tile_of(int p) { return MODE == 0 ? p : 9 * (p >> 3) + 1 + (p & 7); }
    static __device__ __forceinline__ int panel_of(int pm) { return MODE == 0 ? pm : (pm / 9) * 8 + (pm % 9) - 1; }
    static constexpr int NPANEL = MODE == 0 ? 288 : 256;
    __device__ __forceinline__ void init(int G_, int c_, unsigned* cnt_) { G = G_; c = c_; cnt = cnt_; }
    __device__ __forceinline__ bool next(int i, Unit& u) const {
        const long L = (long)i * G + c; if (L >= NPANEL * 4) return false;
        u.pm = tile_of((int)(L >> 2)); u.pn = (int)(L & 3); return true;
    }
    __device__ __forceinline__ void a_ready(const Unit&) const {}
    __device__ __forceinline__ void done(const Unit& u) const {
        asm volatile("s_waitcnt vmcnt(0)" ::: "memory");
        if ((threadIdx.x & 63) == 0) __hip_atomic_fetch_add(cnt + 64 * panel_of(u.pm), 1u, __ATOMIC_RELAXED, __HIP_MEMORY_SCOPE_AGENT);
    }
};

struct LatentOrder {
    int G, c;
    __device__ __forceinline__ void init(int G_, int c_) { G = G_; c = c_; }
    __device__ __forceinline__ bool next(int i, Unit& u) const {
        const long L = (long)i * G + c; if (L >= 256 * 4) return false;
        const int lt = (int)(L >> 2); u.pm = 9 * (lt >> 3) + 1 + (lt & 7); u.pn = (int)(L & 3); return true;
    }
    __device__ __forceinline__ void a_ready(const Unit&) const {}
    __device__ __forceinline__ void done(const Unit&) const {}
};

struct EpiHeadGate {
    static constexpr bool PERM = true, AFTER_DRAIN = false;
    const bf16_t* Y; const float* PS; bf16_t* O;
    __device__ __forceinline__ void operator()(const f32x4 (&acc)[2][2][4][2], const Unit& u, int wr, int wc, int fr, int fq) const {
        const int row0 = u.pm * BM + wr * 64 + fr, col0 = u.pn * BM + wc * 32 + 8 * fq, hh = u.pn >> 1;
        struct Qh { f32x4 pa[2], pb[2]; u32x4 yv[2][2]; };
        auto issue = [&](int ai, int mh, Qh& q) {
#pragma unroll
            for (int mm = 0; mm < 2; ++mm) { const size_t r = (size_t)(row0 + ai * HALF + (2 * mh + mm) * 16);
                q.pa[mm] = *(const f32x4*)(PS + ((r * 4 + hh) * 4) * 2); q.pb[mm] = *(const f32x4*)(PS + ((r * 4 + hh) * 4) * 2 + 4);
#pragma unroll
                for (int bj = 0; bj < 2; ++bj) q.yv[mm][bj] = *(const u32x4*)(Y + r * 2048 + col0 + bj * HALF); } };
        auto finish = [&](int ai, int mh, const Qh& q, const f32x4 (&a4)[2][2][4][2]) {
#pragma unroll
            for (int mm = 0; mm < 2; ++mm) { const int m = 2 * mh + mm; const size_t r = (size_t)(row0 + ai * HALF + m * 16);
                const f32x4 pa = q.pa[mm], pb = q.pb[mm];
                const float mu = ((pa[0] + pa[2]) + (pb[0] + pb[2])) * (1.0f / 512.0f), ex2 = ((pa[1] + pa[3]) + (pb[1] + pb[3])) * (1.0f / 512.0f);
                const float rstd = __builtin_amdgcn_rsqf(fmaxf(ex2 - mu * mu, 0.f) + 1e-5f);
#pragma unroll
                for (int bj = 0; bj < 2; ++bj) { const u32x4 yv = q.yv[mm][bj];
                    typedef float f32x2_t __attribute__((ext_vector_type(2)));
                    const f32x2_t rs2 = (f32x2_t){rstd, rstd}, nm2 = (f32x2_t){-mu * rstd, -mu * rstd}, one2 = (f32x2_t){1.0f, 1.0f}, nl2 = (f32x2_t){-1.4426950408889634f, -1.4426950408889634f};
                    const unsigned yw[4] = {yv.x, yv.y, yv.z, yv.w}; unsigned ow[4];
#pragma unroll
                    for (int p = 0; p < 4; ++p) { const f32x4 g4 = a4[ai][bj][m][p >> 1];
                        const f32x2_t g2 = (p & 1) ? (f32x2_t){g4[2], g4[3]} : (f32x2_t){g4[0], g4[1]};
                        const f32x2_t y2 = (f32x2_t){__builtin_bit_cast(float, yw[p] << 16), __builtin_bit_cast(float, yw[p] & 0xffff0000u)};
                        const f32x2_t yn = y2 * rs2 + nm2, t2 = g2 * nl2;
                        const f32x2_t d2 = (f32x2_t){__builtin_amdgcn_exp2f(t2[0]), __builtin_amdgcn_exp2f(t2[1])} + one2;
                        const f32x2_t r2 = (f32x2_t){__builtin_amdgcn_rcpf(d2[0]), __builtin_amdgcn_rcpf(d2[1])};
                        const f32x2_t o2 = yn * (g2 * r2);
                        ow[p] = cvt_pk_bf16(o2[0], o2[1]); }
                    u32x4 w; w.x = ow[0]; w.y = ow[1]; w.z = ow[2]; w.w = ow[3];
                    *(u32x4*)(O + r * 2048 + col0 + bj * HALF) = w; } } };
        Qh qa, qb;
        issue(0, 0, qa); issue(0, 1, qb); finish(0, 0, qa, acc); issue(1, 0, qa); finish(0, 1, qb, acc); issue(1, 1, qb); finish(1, 0, qa, acc); finish(1, 1, qb, acc);
    }
};
struct EpiRopeQKV {
    static constexpr bool PERM = true, AFTER_DRAIN = false;
    bf16_t* O; const float* TR; int tile0;
    __device__ __forceinline__ void operator()(const f32x4 (&acc)[2][2][4][2], const Unit& u, int wr, int wc, int fr, int fq) const {
        const int tile = tile0 + u.pm, b = tile / 9, st = tile - 9 * b, region = u.pn >> 2;
        const int row0 = u.pm * BM + wr * 64 + fr, col0 = u.pn * BM + wc * 32 + 8 * fq;
        const float sc = region == 1 ? 0.0625f : 1.0f; const bool rot = region < 2 && st != 0;
        const int j0 = (wc * 32 + 8 * fq) >> 1;
        f32x4 tca[2], tcb[2], tma[4], tmb[4];
#pragma unroll
        for (int ai = 0; ai < 2; ++ai) { const int pos = st == 0 ? 0 : 4 * (st - 1) + 2 * ai + wr; tca[ai] = *(const f32x4*)(TR + (pos * 64 + j0) * 2); tcb[ai] = *(const f32x4*)(TR + (pos * 64 + j0) * 2 + 4); }
#pragma unroll
        for (int m = 0; m < 4; ++m) { const int pos = 16 * m + fr; tma[m] = *(const f32x4*)(TR + (pos * 64 + j0) * 2); tmb[m] = *(const f32x4*)(TR + (pos * 64 + j0) * 2 + 4); }
        __builtin_amdgcn_s_waitcnt(0x0F70);
#pragma unroll
        for (int ai = 0; ai < 2; ++ai)
#pragma unroll
            for (int m = 0; m < 4; ++m) { bf16_t* rowp = O + (size_t)(row0 + ai * HALF + m * 16) * 4096 + col0;
#pragma unroll
                for (int bj = 0; bj < 2; ++bj) { f32x4 v0 = acc[ai][bj][m][0], v1 = acc[ai][bj][m][1];
                    if (rot) { const f32x4 ca = bj ? tma[m] : tca[ai], cb = bj ? tmb[m] : tcb[ai];
                        const f32x4 a0 = v0, a1 = v1;
                        v0[0] = a0[0] * ca[0] - a0[1] * ca[1]; v0[1] = a0[1] * ca[0] + a0[0] * ca[1]; v0[2] = a0[2] * ca[2] - a0[3] * ca[3]; v0[3] = a0[3] * ca[2] + a0[2] * ca[3];
                        v1[0] = a1[0] * cb[0] - a1[1] * cb[1]; v1[1] = a1[1] * cb[0] + a1[0] * cb[1]; v1[2] = a1[2] * cb[2] - a1[3] * cb[3]; v1[3] = a1[3] * cb[2] + a1[2] * cb[3]; }
                    v0 = v0 * sc; v1 = v1 * sc;
                    u32x4 w; w.x = cvt_pk_bf16(v0[0], v0[1]); w.y = cvt_pk_bf16(v0[2], v0[3]); w.z = cvt_pk_bf16(v1[0], v1[1]); w.w = cvt_pk_bf16(v1[2], v1[3]);
                    *(u32x4*)(rowp + bj * HALF) = w; } }
        (void)b;
    }
};

struct EpiScatterBf16 {
    static constexpr bool PERM = true, AFTER_DRAIN = false;
    bf16_t* O; const int* drow; int pnmask;
    __device__ __forceinline__ void operator()(const f32x4 (&acc)[2][2][4][2], const Unit& u, int wr, int wc, int fr, int fq) const {
        const int row0 = u.pm * BM + wr * 64 + fr, col0 = (u.pn & pnmask) * BM + wc * 32 + 8 * fq;
        int dr[2][4];
#pragma unroll
        for (int ai = 0; ai < 2; ++ai)
#pragma unroll
            for (int m = 0; m < 4; ++m) dr[ai][m] = drow[row0 + ai * HALF + m * 16];
#pragma unroll
        for (int ai = 0; ai < 2; ++ai)
#pragma unroll
            for (int m = 0; m < 4; ++m) { bf16_t* rowp = O + (size_t)dr[ai][m] * 1024 + col0;
#pragma unroll
                for (int bj = 0; bj < 2; ++bj) { const f32x4 v0 = acc[ai][bj][m][0], v1 = acc[ai][bj][m][1];
                    u32x4 w; w.x = cvt_pk_bf16(v0[0], v0[1]); w.y = cvt_pk_bf16(v0[2], v0[3]); w.z = cvt_pk_bf16(v1[0], v1[1]); w.w = cvt_pk_bf16(v1[2], v1[3]);
                    *(u32x4*)(rowp + bj * HALF) = w; } }
    }
};

struct EpiQKNorm {
    static constexpr bool PERM = true, AFTER_DRAIN = false;
    bf16_t* O; const float* TA; const float* qgain; const float* kgain; PG8_LAS float* xl;
    __device__ __forceinline__ void operator()(const f32x4 (&acc)[2][2][4][2], const Unit& u, int wr, int wc, int fr, int fq) const {
        const int b = u.pm / 9, st = u.pm - 9 * b;
        const int row0 = u.pm * BM + wr * 64 + fr, col0 = u.pn * BM + wc * 32 + 8 * fq;
        if (u.pn >= 5) {
#pragma unroll
            for (int ai = 0; ai < 2; ++ai)
#pragma unroll
                for (int m = 0; m < 4; ++m) { bf16_t* rowp = O + (size_t)(row0 + ai * HALF + m * 16) * 1536 + col0;
#pragma unroll
                    for (int bj = 0; bj < 2; ++bj) { const f32x4 v0 = acc[ai][bj][m][0], v1 = acc[ai][bj][m][1];
                        u32x4 w; w.x = cvt_pk_bf16(v0[0], v0[1]); w.y = cvt_pk_bf16(v0[2], v0[3]); w.z = cvt_pk_bf16(v1[0], v1[1]); w.w = cvt_pk_bf16(v1[2], v1[3]);
                        *(u32x4*)(rowp + bj * HALF) = w; } }
            return; }
#pragma unroll
        for (int ai = 0; ai < 2; ++ai)
#pragma unroll
            for (int m = 0; m < 4; ++m)
#pragma unroll
                for (int bj = 0; bj < 2; ++bj) { const f32x4 v0 = acc[ai][bj][m][0], v1 = acc[ai][bj][m][1];
                    float s = (v0[0] * v0[0] + v0[1] * v0[1]) + (v0[2] * v0[2] + v0[3] * v0[3]) + (v1[0] * v1[0] + v1[1] * v1[1]) + (v1[2] * v1[2] + v1[3] * v1[3]);
                    s += __shfl_xor(s, 16); s += __shfl_xor(s, 32);
                    if (fq == 0) xl[((ai * HALF + wr * 64 + m * 16 + fr) * 2 + bj) * 4 + wc] = s; }
        asm volatile("s_waitcnt lgkmcnt(0)" ::: "memory"); __builtin_amdgcn_s_barrier(); asm volatile("" ::: "memory");
        const float* gn = (u.pn < 4 ? qgain : kgain) + wc * 32 + 8 * fq;
        const f32x4 g0 = *(const f32x4*)gn, g1 = *(const f32x4*)(gn + 4);
        const int j0 = 16 * (wc & 1) + 4 * fq; const bool rot = st != 0, second = (wc >> 1) != 0;
        f32x4 tpa[4], tpb[4];
#pragma unroll
        for (int q = 0; q < 4; ++q) { const int pos = second ? 16 * q + fr : (rot ? 4 * (st - 1) + 2 * (q & 1) + wr : 0);
            const f32x4 la = *(const f32x4*)(TA + (pos * 32 + j0) * 2), lb = *(const f32x4*)(TA + (pos * 32 + j0) * 2 + 4), id = (f32x4){1.f, 0.f, 1.f, 0.f};
            tpa[q] = rot ? la : id; tpb[q] = rot ? lb : id; }
#pragma unroll
        for (int ai = 0; ai < 2; ++ai)
#pragma unroll
            for (int m = 0; m < 4; ++m) { const int rt = ai * HALF + wr * 64 + m * 16 + fr; bf16_t* rowp = O + (size_t)(row0 + ai * HALF + m * 16) * 1536 + col0;
                const f32x4 ca = second ? tpa[m] : tpa[ai], cb = second ? tpb[m] : tpb[ai];
#pragma unroll
                for (int bj = 0; bj < 2; ++bj) { const f32x4 p4 = *(const PG8_LAS f32x4*)(xl + (rt * 2 + bj) * 4);
                    const float rinv = __builtin_amdgcn_rsqf(((p4[0] + p4[1]) + (p4[2] + p4[3])) * (1.0f / 128.0f) + 1e-6f);
                    const f32x4 a0 = acc[ai][bj][m][0] * rinv * g0, a1 = acc[ai][bj][m][1] * rinv * g1; f32x4 v0, v1;
                    v0[0] = a0[0] * ca[0] - a0[1] * ca[1]; v0[1] = a0[1] * ca[0] + a0[0] * ca[1]; v0[2] = a0[2] * ca[2] - a0[3] * ca[3]; v0[3] = a0[3] * ca[2] + a0[2] * ca[3];
                    v1[0] = a1[0] * cb[0] - a1[1] * cb[1]; v1[1] = a1[1] * cb[0] + a1[0] * cb[1]; v1[2] = a1[2] * cb[2] - a1[3] * cb[3]; v1[3] = a1[3] * cb[2] + a1[2] * cb[3];
                    u32x4 w; w.x = cvt_pk_bf16(v0[0], v0[1]); w.y = cvt_pk_bf16(v0[2], v0[3]); w.z = cvt_pk_bf16(v1[0], v1[1]); w.w = cvt_pk_bf16(v1[2], v1[3]);
                    *(u32x4*)(rowp + bj * HALF) = w; } }
        asm volatile("s_waitcnt lgkmcnt(0)" ::: "memory"); __builtin_amdgcn_s_barrier(); asm volatile("" ::: "memory");
    }
};
template <class Epi, class Sched, bool ALIGN_EPI = false, bool SP2 = false, bool GATHER = false>
__device__ __forceinline__ void gemm_phase(PG8_LAS unsigned char* lds, const Gemm g, const Sched& S, const Epi& E) {
    const int tid = threadIdx.x, wid = __builtin_amdgcn_readfirstlane(tid >> 6), lane = tid & 63, wr = wid >> 2, wc = wid & 3, fr = lane & 15, fq = lane >> 4;
    const int K = g.K, nt = K / BK;
    unsigned voffA[2], voffB[2];
#pragma unroll
    for (int i = 0; i < 2; ++i) { int R, C; stage_rc(tid * 16 + i * 8192, R, C); const int Rb = Epi::PERM ? ((R & ~31) + perm32(R & 31)) : R;
        voffA[i] = (unsigned)(R * K + C) * 2u; voffB[i] = (unsigned)(Rb * K + C) * 2u; }
    const size_t kstep = (size_t)(BK * 2);
    const size_t hstep = (size_t)HALF * K * 2;
    const size_t tstep = 2 * hstep;
    static_assert(!GATHER || SP2, "the gathered A operand is wired into the SP2 loop only");
    const size_t hstepA = GATHER ? (size_t)0 : hstep, tstepA = GATHER ? (size_t)0 : tstep;
    unsigned vc0[2], vc1[2], vn0[2], vn1[2];
#define PG8_VLOAD(u_, d0_, d1_) do { _Pragma("unroll") for (int _i = 0; _i < 2; ++_i) { if constexpr (GATHER) { int R_, C_; stage_rc(tid * 16 + _i * 8192, R_, C_); \
        d0_[_i] = (unsigned)g.rowidx[(u_).pm * BM + R_] * (unsigned)(K * 2) + (unsigned)(C_ * 2); d1_[_i] = (unsigned)g.rowidx[(u_).pm * BM + HALF + R_] * (unsigned)(K * 2) + (unsigned)(C_ * 2); } \
        else { d0_[_i] = voffA[_i]; d1_[_i] = voffA[_i]; } } } while (0)
    const unsigned ldsw = (unsigned)wid * 1024u;
    const int aoff = lds_byte(wr * 64 + fr, fq * 8), boff = lds_byte(wc * 32 + fr, fq * 8);
#define PG8_SA(b, h) (((b) * 2 + (h)) * HTB)
#define PG8_SB(b, h) ((4 + (b) * 2 + (h)) * HTB)
#define PG8_STAGE(bufoff, gbase, voff) do { _Pragma("unroll") for (int _i = 0; _i < 2; ++_i) \
        __builtin_amdgcn_global_load_lds((const unsigned*)((const char*)(gbase) + (voff)[_i]), (PG8_LAS unsigned*)(lds + (bufoff) + ldsw + _i * 8192), 16, 0, 0); } while (0)
#define PG8_LDA(dst, b, h) do { _Pragma("unroll") for (int m = 0; m < 4; ++m) _Pragma("unroll") for (int k = 0; k < 2; ++k) dst[m][k] = *(const PG8_LAS bf16x8*)(lds + PG8_SA(b, h) + aoff + m * 2048 + k * 1024); } while (0)
#define PG8_LDB(dst, b, h) do { _Pragma("unroll") for (int n = 0; n < 2; ++n) _Pragma("unroll") for (int k = 0; k < 2; ++k) dst[n][k] = *(const PG8_LAS bf16x8*)(lds + PG8_SB(b, h) + boff + n * 2048 + k * 1024); } while (0)
#define PG8_MMA(ai, bj, At, Bt) do { __builtin_amdgcn_s_setprio(1); _Pragma("unroll") for (int m = 0; m < 4; ++m) _Pragma("unroll") for (int n = 0; n < 2; ++n) _Pragma("unroll") for (int k = 0; k < 2; ++k) \
        acc[ai][bj][m][n] = __builtin_amdgcn_mfma_f32_16x16x32_bf16(Bt[n][k], At[m][k], acc[ai][bj][m][n], 0, 0, 0); __builtin_amdgcn_s_setprio(0); } while (0)
#define PG8_WAIT_V(n) asm volatile("s_waitcnt vmcnt(" #n ")" ::: "memory")
#define PG8_WAIT_L(n) asm volatile("s_waitcnt lgkmcnt(" #n ")" ::: "memory")
#define PG8_BAR __builtin_amdgcn_s_barrier()
#define PG8_SCHED __builtin_amdgcn_sched_barrier(0)
    Unit cur, nxt; int ui = 0; unsigned prb_sum = 0u, prb_t = 0u;
    if (!S.next(0, cur)) return;
    f32x4 acc[2][2][4][2];
#pragma unroll
    for (int a = 0; a < 2; ++a)
#pragma unroll
        for (int b = 0; b < 2; ++b)
#pragma unroll
            for (int m = 0; m < 4; ++m)
#pragma unroll
                for (int n = 0; n < 2; ++n) acc[a][b][m][n] = (f32x4){0.f, 0.f, 0.f, 0.f};
    bf16x8 At[4][2], B0[2][2], B1[2][2];
    PG8_VLOAD(cur, vc0, vc1);
    const char* cA = (const char*)g.A + (size_t)cur.pm * tstepA; const char* cB = (const char*)g.Bt + (size_t)cur.pn * tstep;
    S.a_ready(cur);
    if constexpr (SP2) {
        PG8_STAGE(PG8_SB(0, 0), cB, voffB); PG8_STAGE(PG8_SB(0, 1), cB + hstep, voffB); PG8_STAGE(PG8_SA(0, 0), cA, vc0); PG8_STAGE(PG8_SA(0, 1), cA + hstepA, vc1);
        if (wr == 1) PG8_BAR;
        PG8_WAIT_V(2); PG8_BAR;
        PG8_STAGE(PG8_SB(1, 0), cB + kstep, voffB); PG8_STAGE(PG8_SA(1, 0), cA + kstep, vc0); PG8_STAGE(PG8_SB(1, 1), cB + hstep + kstep, voffB);
        PG8_WAIT_V(6); PG8_BAR;
    } else {
        PG8_STAGE(PG8_SB(0, 0), cB, voffB); PG8_STAGE(PG8_SA(0, 0), cA, voffA); PG8_STAGE(PG8_SB(0, 1), cB + hstep, voffB); PG8_STAGE(PG8_SA(0, 1), cA + hstep, voffA);
        if (wr == 1) PG8_BAR;
        PG8_WAIT_V(4); PG8_BAR;
        PG8_STAGE(PG8_SB(1, 0), cB + kstep, voffB); PG8_STAGE(PG8_SA(1, 0), cA + kstep, voffA); PG8_STAGE(PG8_SB(1, 1), cB + hstep + kstep, voffB);
        PG8_WAIT_V(6); PG8_BAR;
    }
    for (;;) {
        const bool has_next = S.next(ui + 1, nxt);
        if (has_next) PG8_VLOAD(nxt, vn0, vn1); else { vn0[0] = vc0[0]; vn0[1] = vc0[1]; vn1[0] = vc1[0]; vn1[1] = vc1[1]; }
        const char* nA = has_next ? (const char*)g.A + (size_t)nxt.pm * tstepA : cA; const char* nB = has_next ? (const char*)g.Bt + (size_t)nxt.pn * tstep : cB;
        if (PROBE_PHASE >= 0 && PROBE_KIND == 2) prb_t = (unsigned)__builtin_amdgcn_s_memrealtime();
        if (PROBE_PHASE >= 0 && PROBE_KIND == 5) prb_t = (unsigned)(__builtin_amdgcn_s_memtime() >> 5);
        for (int t = 0; t < nt; t += 2) {
            if (PROBE_PHASE >= 0 && PROBE_KIND == 3) { if (t == 0) prb_t = (unsigned)__builtin_amdgcn_s_memrealtime(); else if (t == 2) prb_sum += (unsigned)__builtin_amdgcn_s_memrealtime() - prb_t; }
            const bool last = (t == nt - 2);
            const char* a1 = cA + (size_t)(t + 1) * kstep;
            const char* a2 = last ? nA : cA + (size_t)(t + 2) * kstep; const char* b2 = last ? nB : cB + (size_t)(t + 2) * kstep;
            const char* a3 = a2 + kstep; const char* b3 = b2 + kstep;
            if (last && has_next) S.a_ready(nxt);
            unsigned s0[2], s1[2]; s0[0] = last ? vn0[0] : vc0[0]; s0[1] = last ? vn0[1] : vc0[1]; s1[0] = last ? vn1[0] : vc1[0]; s1[1] = last ? vn1[1] : vc1[1];
            if constexpr (SP2) {
            PG8_LDB(B0, 0, 0); PG8_LDB(B1, 0, 1); PG8_SCHED; PG8_LDA(At, 0, 0); PG8_STAGE(PG8_SA(1, 1), a1 + hstepA, vc1);
            PG8_WAIT_V(8); PG8_WAIT_L(0); PG8_BAR; PG8_MMA(0, 0, At, B0); PG8_MMA(0, 1, At, B1); PG8_BAR; PG8_SCHED;
            PG8_LDA(At, 0, 1); PG8_STAGE(PG8_SB(0, 0), b2, voffB); PG8_STAGE(PG8_SB(0, 1), b2 + hstep, voffB); PG8_STAGE(PG8_SA(0, 0), a2, s0);
            PG8_WAIT_V(8); PG8_WAIT_L(0); PG8_BAR; PG8_MMA(1, 0, At, B0); PG8_MMA(1, 1, At, B1); PG8_BAR; PG8_SCHED;
            PG8_LDB(B0, 1, 0); PG8_LDB(B1, 1, 1); PG8_SCHED; PG8_LDA(At, 1, 0); PG8_STAGE(PG8_SA(0, 1), a2 + hstepA, s1);
            PG8_WAIT_V(8); PG8_WAIT_L(0); PG8_BAR; PG8_MMA(0, 0, At, B0); PG8_MMA(0, 1, At, B1); PG8_BAR; PG8_SCHED;
            PG8_LDA(At, 1, 1); PG8_STAGE(PG8_SB(1, 0), b3, voffB); PG8_STAGE(PG8_SB(1, 1), b3 + hstep, voffB); PG8_STAGE(PG8_SA(1, 0), a3, s0);
            PG8_WAIT_V(8); PG8_WAIT_L(0); PG8_BAR; PG8_MMA(1, 0, At, B0); PG8_MMA(1, 1, At, B1); PG8_BAR; PG8_SCHED;
            } else {
            PG8_LDB(B0, 0, 0); PG8_SCHED; PG8_LDA(At, 0, 0); PG8_STAGE(PG8_SA(1, 1), a1 + hstep, voffA);
            PG8_WAIT_L(8); PG8_BAR; PG8_WAIT_L(0); PG8_MMA(0, 0, At, B0); PG8_BAR; PG8_SCHED;
            PG8_LDB(B1, 0, 1); PG8_STAGE(PG8_SB(0, 0), b2, voffB);
            PG8_BAR; PG8_WAIT_L(0); PG8_MMA(0, 1, At, B1); PG8_BAR;
            PG8_LDA(At, 0, 1); PG8_STAGE(PG8_SA(0, 0), a2, voffA);
            PG8_BAR; PG8_WAIT_L(0); PG8_MMA(1, 0, At, B0); PG8_BAR; PG8_SCHED;
            PG8_STAGE(PG8_SB(0, 1), b2 + hstep, voffB);
            PG8_WAIT_V(6); PG8_BAR; PG8_MMA(1, 1, At, B1); PG8_BAR;
            PG8_LDB(B0, 1, 0); PG8_SCHED; PG8_LDA(At, 1, 0); PG8_STAGE(PG8_SA(0, 1), a2 + hstep, voffA);
            PG8_WAIT_L(8); PG8_BAR; PG8_WAIT_L(0); PG8_MMA(0, 0, At, B0); PG8_BAR; PG8_SCHED;
            PG8_LDB(B1, 1, 1); PG8_STAGE(PG8_SB(1, 0), b3, voffB);
            PG8_BAR; PG8_WAIT_L(0); PG8_MMA(0, 1, At, B1); PG8_BAR;
            PG8_LDA(At, 1, 1); PG8_STAGE(PG8_SA(1, 0), a3, voffA);
            PG8_BAR; PG8_WAIT_L(0); PG8_MMA(1, 0, At, B0); PG8_BAR; PG8_SCHED;
            PG8_STAGE(PG8_SB(1, 1), b3 + hstep, voffB);
            PG8_WAIT_V(6); PG8_BAR; PG8_MMA(1, 1, At, B1); PG8_BAR;
            }
        }
        if (PROBE_PHASE >= 0 && PROBE_KIND == 2) prb_sum += (unsigned)__builtin_amdgcn_s_memrealtime() - prb_t;
        if (PROBE_PHASE >= 0 && PROBE_KIND == 5) prb_sum += (unsigned)(__builtin_amdgcn_s_memtime() >> 5) - prb_t;
        if (PROBE_PHASE >= 0 && PROBE_KIND == 1) prb_t = (unsigned)__builtin_amdgcn_s_memrealtime();
        if constexpr (ALIGN_EPI) { if (wr == 0) PG8_BAR; }
        if constexpr (!Epi::AFTER_DRAIN) { E(acc, cur, wr, wc, fr, fq); S.done(cur); }
        if (PROBE_PHASE >= 0 && PROBE_KIND == 1) prb_sum += (unsigned)__builtin_amdgcn_s_memrealtime() - prb_t;
        if (PROBE_PHASE >= 0 && PROBE_KIND >= 1 && !has_next && blockIdx.x == 0 && wid == 0) { volatile __attribute__((address_space(3))) unsigned* w = PRB_W(lds); if (w[0]) w[2] += prb_sum; }
        if (!has_next) break;
#pragma unroll
        for (int a = 0; a < 2; ++a)
#pragma unroll
            for (int b = 0; b < 2; ++b)
#pragma unroll
                for (int m = 0; m < 4; ++m)
#pragma unroll
                    for (int n = 0; n < 2; ++n) acc[a][b][m][n] = (f32x4){0.f, 0.f, 0.f, 0.f};
        cur = nxt; cA = nA; cB = nB; ++ui; vc0[0] = vn0[0]; vc0[1] = vn0[1]; vc1[0] = vn1[0]; vc1[1] = vn1[1];
        if constexpr (ALIGN_EPI) { if (wr == 1) PG8_BAR; }
    }
    PG8_WAIT_V(0);
    if constexpr (!ALIGN_EPI) { if (wr == 0) PG8_BAR; }
    PG8_BAR;
    if constexpr (Epi::AFTER_DRAIN) { E.fused(acc, cur, wr, wc, fr, fq, lds, wid, lane); S.done(cur); }
#undef PG8_VLOAD
#undef PG8_SA
#undef PG8_SB
#undef PG8_STAGE
#undef PG8_LDA
#undef PG8_LDB
#undef PG8_MMA
#undef PG8_WAIT_V
#undef PG8_WAIT_L
#undef PG8_BAR
#undef PG8_SCHED
}
}
namespace att {
using bf16 = unsigned short;
constexpr int   D = 128, NW = 8, QBLK = 32, KVBLK = 64;
constexpr float SCALE = 0.088388347648318440f;
constexpr float THR = 8.f;
constexpr int SDEPTH = 2;
constexpr int LDQ = 1536, LDK = 1536, LDO = 1024;
constexpr size_t SHM_V = KVBLK * D * 2, SHM_K = KVBLK * D * 2, SHM_ATTN = 2 * SHM_V + 2 * SHM_K + NW * 64 * 4;
__device__ __forceinline__ unsigned short f2bf16(float f) { unsigned u = __builtin_bit_cast(unsigned, f); return (unsigned short)((u + 0x7fffu + ((u >> 16) & 1u)) >> 16); }
using bf16x8 = __attribute__((ext_vector_type(8))) short;
using s16x4  = __attribute__((ext_vector_type(4))) short;
using f32x16 = __attribute__((ext_vector_type(16))) float;
using f32x8  = __attribute__((ext_vector_type(8))) float;
using u32x4  = __attribute__((ext_vector_type(4))) unsigned;
#define KSWZ(row, colB) ((row) * 256 + ((colB) ^ (((row) & 7) << 4)))
#define SBAR() __builtin_amdgcn_sched_barrier(0)
__device__ __forceinline__ int crow(int r, int hi) { return (r & 3) + 8 * (r >> 2) + 4 * hi; }
__device__ __forceinline__ unsigned cvtpk(float lo, float hi) {
  unsigned r; asm volatile("v_cvt_pk_bf16_f32 %0, %1, %2" : "=v"(r) : "v"(lo), "v"(hi)); return r;
}
template <typename TIn> struct Stage;
template <> struct Stage<bf16>  { using T = bf16x8;
  __device__ static __forceinline__ T ld8(const bf16* p) { return *reinterpret_cast<const bf16x8*>(p); }
  __device__ static __forceinline__ bf16x8 tobf(T x) { return x; } };
template <> struct Stage<float> { using T = f32x8;
  __device__ static __forceinline__ T ld8(const float* p) { return *reinterpret_cast<const f32x8*>(p); }
  __device__ static __forceinline__ bf16x8 tobf(T x) {
    u32x4 w = {cvtpk(x[0], x[1]), cvtpk(x[2], x[3]), cvtpk(x[4], x[5]), cvtpk(x[6], x[7])}; return *reinterpret_cast<bf16x8*>(&w); } };

__device__ __forceinline__ void partialSM(f32x16& p0, f32x16& p1, float& m_reg, float& mn, float& alpha) {
  constexpr float C = SCALE * 1.4426950408889634f;
  float pmax = p0[0]; for (int r = 1; r < 16; ++r) pmax = fmaxf(pmax, p0[r]); for (int r = 0; r < 16; ++r) pmax = fmaxf(pmax, p1[r]);
  { auto rr = __builtin_amdgcn_permlane32_swap(__float_as_uint(pmax), __float_as_uint(pmax), false, false);
    pmax = fmaxf(__uint_as_float(rr[0]), __uint_as_float(rr[1])); }
  if (__builtin_expect(__all(pmax - m_reg <= THR / SCALE), 1)) { mn = m_reg; alpha = 1.f; }
  else { mn = fmaxf(m_reg, pmax); alpha = __builtin_amdgcn_exp2f((m_reg - mn) * C); m_reg = mn; }
  float mnC = -mn * C;
  for (int r = 0; r < 16; ++r) p0[r] = fmaf(p0[r], C, mnC); for (int r = 0; r < 16; ++r) p1[r] = fmaf(p1[r], C, mnC);
  for (int r = 0; r < 16; ++r) p0[r] = __builtin_amdgcn_exp2f(p0[r]);
}
__device__ __forceinline__ void finishSM(f32x16& p0, f32x16& p1, float alpha, float& l_reg, bf16x8& pa0, bf16x8& pa1, bf16x8& pa2, bf16x8& pa3) {
  for (int r = 0; r < 16; ++r) p1[r] = __builtin_amdgcn_exp2f(p1[r]);
  float ps = 0; for (int r = 0; r < 16; ++r) ps += p0[r]; for (int r = 0; r < 16; ++r) ps += p1[r];
  { auto rr = __builtin_amdgcn_permlane32_swap(__float_as_uint(ps), __float_as_uint(ps), false, false);
    ps = __uint_as_float(rr[0]) + __uint_as_float(rr[1]); }
  l_reg = l_reg * alpha + ps;
#define PK4(P, BASE, OUT) do { unsigned a0 = cvtpk(P[BASE + 0], P[BASE + 1]), a1 = cvtpk(P[BASE + 2], P[BASE + 3]);   \
    unsigned b0 = cvtpk(P[BASE + 4], P[BASE + 5]), b1 = cvtpk(P[BASE + 6], P[BASE + 7]);                              \
    auto r0 = __builtin_amdgcn_permlane32_swap(a0, b0, false, false); auto r1 = __builtin_amdgcn_permlane32_swap(a1, b1, false, false); \
    u32x4 w = {r0[0], r1[0], r0[1], r1[1]}; OUT = *reinterpret_cast<bf16x8*>(&w); } while (0)
  PK4(p0, 0, pa0); PK4(p0, 8, pa1); PK4(p1, 0, pa2); PK4(p1, 8, pa3);
#undef PK4
}
__device__ __forceinline__ void qkt(f32x16& p0, f32x16& p1, const bf16* Ks, const bf16x8* qr, int r32, int hi) {
  p0 = f32x16{}; p1 = f32x16{};
  for (int d0 = 0; d0 < 8; ++d0) { int cb = (d0 * 16 + hi * 8) * 2;
    bf16x8 b0 = *reinterpret_cast<const bf16x8*>((const char*)Ks + KSWZ(r32, cb));
    bf16x8 b1 = *reinterpret_cast<const bf16x8*>((const char*)Ks + KSWZ(32 + r32, cb));
    p0 = __builtin_amdgcn_mfma_f32_32x32x16_bf16(b0, qr[d0], p0, 0, 0, 0);
    p1 = __builtin_amdgcn_mfma_f32_32x32x16_bf16(b1, qr[d0], p1, 0, 0, 0); }
}
__device__ __forceinline__ int v_st(int k, int c) { const int kk = (k & ~0xC) | ((k & 4) << 1) | ((k & 8) >> 1); return ((kk >> 3) * 4 + (c >> 5)) * 512 + ((kk & 7) * 32 + (c & 31)) * 2; }
__device__ __forceinline__ int v_rd_base(int lane) { return ((lane & 3) << 3) | (((lane >> 2) & 3) << 6) | (((lane >> 4) & 1) << 5) | (((lane >> 5) & 1) << 8); }
constexpr int v_rd_off(int d0, int ks, int half) { return d0 * 512 + ks * 4096 + half * 2048; }
template <int OFF> __device__ __forceinline__ s16x4 tr_read(int vb) {
  s16x4 r; asm volatile("ds_read_b64_tr_b16 %0, %1 offset:%2" : "=&v"(r) : "v"(vb), "i"(OFF) : "memory"); return r;
}
template <int D0> __device__ __forceinline__ void pv_one(f32x16& od, int vb, bf16x8 pa0, bf16x8 pa1, bf16x8 pa2, bf16x8 pa3) {
  const s16x4 l0 = tr_read<v_rd_off(D0, 0, 0)>(vb), h0 = tr_read<v_rd_off(D0, 0, 1)>(vb), l1 = tr_read<v_rd_off(D0, 1, 0)>(vb), h1 = tr_read<v_rd_off(D0, 1, 1)>(vb);
  const s16x4 l2 = tr_read<v_rd_off(D0, 2, 0)>(vb), h2 = tr_read<v_rd_off(D0, 2, 1)>(vb), l3 = tr_read<v_rd_off(D0, 3, 0)>(vb), h3 = tr_read<v_rd_off(D0, 3, 1)>(vb);
  asm volatile("s_waitcnt lgkmcnt(0)" ::: "memory"); SBAR();
#define PK(L, H) (bf16x8){L[0], L[1], L[2], L[3], H[0], H[1], H[2], H[3]}
  od = __builtin_amdgcn_mfma_f32_32x32x16_bf16(pa0, PK(l0, h0), od, 0, 0, 0);
  od = __builtin_amdgcn_mfma_f32_32x32x16_bf16(pa1, PK(l1, h1), od, 0, 0, 0);
  od = __builtin_amdgcn_mfma_f32_32x32x16_bf16(pa2, PK(l2, h2), od, 0, 0, 0);
  od = __builtin_amdgcn_mfma_f32_32x32x16_bf16(pa3, PK(l3, h3), od, 0, 0, 0);
#undef PK
}
__device__ __forceinline__ void pv_d0(f32x16* o, int vb, bf16x8 pa0, bf16x8 pa1, bf16x8 pa2, bf16x8 pa3) {
  pv_one<0>(o[0], vb, pa0, pa1, pa2, pa3); pv_one<1>(o[1], vb, pa0, pa1, pa2, pa3); pv_one<2>(o[2], vb, pa0, pa1, pa2, pa3); pv_one<3>(o[3], vb, pa0, pa1, pa2, pa3);
}

template <typename TQ, int LDQ_ = LDQ, int LDK_ = LDK>
__device__ __forceinline__ void attn_dense_body(const TQ* __restrict__ Qb, const bf16* __restrict__ Kh, const bf16* __restrict__ Vh,
                                                bf16* __restrict__ Ob, int seq, char* lds) {
  using St = Stage<bf16>; using SQ = Stage<TQ>;
  const int tid = threadIdx.x, wid = tid >> 6, lane = tid & 63, r32 = lane & 31, hi = lane >> 5;
  bf16* V_lds = (bf16*)lds; bf16* K_lds = (bf16*)(lds + 2 * SHM_V);
  float* ws = (float*)(lds + 2 * SHM_V + 2 * SHM_K) + wid * 64; float* li_l = ws; float* al_l = ws + 32;
  float m_reg = -1e30f, l_reg = 0; f32x16 o[4] = {}; bf16x8 qr[8];
  const TQ* Qw = Qb + (long)(wid * QBLK + r32) * LDQ_ + hi * 8;
#pragma unroll
  for (int d0 = 0; d0 < 8; ++d0) qr[d0] = SQ::tobf(SQ::ld8(Qw + d0 * 16));
  const int sr = tid >> 4, sc = (tid & 15) * 8, vst0 = v_st(sr, sc), vst1 = v_st(32 + sr, sc);
  const int vb0 = (int)(uintptr_t)V_lds + v_rd_base(lane);
  struct { typename St::T vs0, vs1, ks0, ks1; } sr_[SDEPTH];
#define SLOAD(i, k0) do { sr_[i].vs0 = St::ld8(&Vh[(long)((k0) + sr) * LDK_ + sc]); sr_[i].vs1 = St::ld8(&Vh[(long)((k0) + 32 + sr) * LDK_ + sc]); \
    sr_[i].ks0 = St::ld8(&Kh[(long)((k0) + sr) * LDK_ + sc]); sr_[i].ks1 = St::ld8(&Kh[(long)((k0) + 32 + sr) * LDK_ + sc]); } while (0)
#define SWRITE(b, i) do { *(bf16x8*)((char*)V_lds + (b) * SHM_V + vst0) = St::tobf(sr_[i].vs0);          \
    *(bf16x8*)((char*)V_lds + (b) * SHM_V + vst1) = St::tobf(sr_[i].vs1); int kc = sc * 2;               \
    *(bf16x8*)((char*)K_lds + (b) * SHM_K + KSWZ(sr, kc)) = St::tobf(sr_[i].ks0);                       \
    *(bf16x8*)((char*)K_lds + (b) * SHM_K + KSWZ(32 + sr, kc)) = St::tobf(sr_[i].ks1); } while (0)
#define SWAIT() do { if constexpr (SDEPTH == 2) asm volatile("s_waitcnt vmcnt(4)" ::: "memory"); else asm volatile("s_waitcnt vmcnt(0)" ::: "memory"); } while (0)
#define RESC(a) do { if (__any((a) < 1.f)) { if (hi == 0) al_l[r32] = (a); asm volatile("s_waitcnt lgkmcnt(0)" ::: "memory"); \
    for (int d = 0; d < 4; ++d) for (int r = 0; r < 16; ++r) o[d][r] *= al_l[crow(r, hi)]; } } while (0)
  f32x16 pA0, pA1, pB0, pB1; float mnA, mnB, alA, alB; bf16x8 pa0, pa1, pa2, pa3; const int NT = seq / KVBLK;
  constexpr int SE = 0, SO = SDEPTH - 1;
  SLOAD(SE, 0); asm volatile("s_waitcnt vmcnt(0)" ::: "memory"); SWRITE(0, SE); __syncthreads();
  qkt(pA0, pA1, K_lds, qr, r32, hi); partialSM(pA0, pA1, m_reg, mnA, alA);
  SLOAD(SO, KVBLK); if constexpr (SDEPTH == 2) { if (2 < NT) SLOAD(SE, 2 * KVBLK); }
  SWAIT(); SWRITE(1, SO); __syncthreads();
  for (int j = 1; j + 1 < NT; j += 2) {
    SBAR(); qkt(pB0, pB1, (bf16*)((char*)K_lds + SHM_K), qr, r32, hi);
    finishSM(pA0, pA1, alA, l_reg, pa0, pa1, pa2, pa3); SBAR();
    SLOAD(SO, (j + SDEPTH) * KVBLK); SBAR();
    pv_d0(o, vb0, pa0, pa1, pa2, pa3); partialSM(pB0, pB1, m_reg, mnB, alB);
    __syncthreads(); SWAIT(); SWRITE(0, SE);
    RESC(alB); __syncthreads();
    SBAR(); qkt(pA0, pA1, K_lds, qr, r32, hi);
    finishSM(pB0, pB1, alB, l_reg, pa0, pa1, pa2, pa3); SBAR();
    if (SDEPTH == 1 || j + 3 < NT) SLOAD(SE, (j + 1 + SDEPTH) * KVBLK); SBAR();
    pv_d0(o, vb0 + (int)SHM_V, pa0, pa1, pa2, pa3); partialSM(pA0, pA1, m_reg, mnA, alA);
    __syncthreads(); SWAIT(); SWRITE(1, SO);
    RESC(alA); __syncthreads();
  }
  SBAR(); qkt(pB0, pB1, (bf16*)((char*)K_lds + SHM_K), qr, r32, hi);
  finishSM(pA0, pA1, alA, l_reg, pa0, pa1, pa2, pa3); SBAR();
  pv_d0(o, vb0, pa0, pa1, pa2, pa3); partialSM(pB0, pB1, m_reg, mnB, alB);
  __syncthreads(); RESC(alB);
  finishSM(pB0, pB1, alB, l_reg, pa0, pa1, pa2, pa3); SBAR();
  pv_d0(o, vb0 + (int)SHM_V, pa0, pa1, pa2, pa3);
  if (hi == 0) li_l[r32] = l_reg; asm volatile("s_waitcnt lgkmcnt(0)" ::: "memory");
  float rli[16];
#pragma unroll
  for (int r = 0; r < 16; ++r) rli[r] = __builtin_amdgcn_rcpf(li_l[crow(r, hi)]);
  bf16* Ow = Ob + (long)(wid * QBLK) * LDO;
#pragma unroll
  for (int r = 0; r < 16; ++r) { int orow = crow(r, hi);
    for (int d0 = 0; d0 < 4; ++d0) Ow[(long)orow * LDO + d0 * 32 + r32] = f2bf16(o[d0][r] * rli[r]); }
#undef SLOAD
#undef SWRITE
#undef SWAIT
#undef RESC
}

__device__ __forceinline__ void q_norm_rope_inplace(bf16* Qb, int t0, const float* __restrict__ qgain, const float* __restrict__ TA) {
  const int tid = threadIdx.x, wid = tid >> 6, lane = tid & 63, r32 = lane & 31, hi = lane >> 5;
  const bf16* Qw = Qb + (long)(wid * QBLK + r32) * LDQ + hi * 8;
  bf16x8 qr[8];
#pragma unroll
  for (int d0 = 0; d0 < 8; ++d0) qr[d0] = *reinterpret_cast<const bf16x8*>(Qw + d0 * 16);
  {
    float qf[8][8]; float ss = 0.f;
#pragma unroll
    for (int d0 = 0; d0 < 8; ++d0) { const u32x4 w = *reinterpret_cast<const u32x4*>(&qr[d0]);
      qf[d0][0] = __uint_as_float(w.x << 16); qf[d0][1] = __uint_as_float(w.x & 0xffff0000u); qf[d0][2] = __uint_as_float(w.y << 16); qf[d0][3] = __uint_as_float(w.y & 0xffff0000u);
      qf[d0][4] = __uint_as_float(w.z << 16); qf[d0][5] = __uint_as_float(w.z & 0xffff0000u); qf[d0][6] = __uint_as_float(w.w << 16); qf[d0][7] = __uint_as_float(w.w & 0xffff0000u);
#pragma unroll
      for (int i = 0; i < 8; ++i) ss += qf[d0][i] * qf[d0][i]; }
    { auto rr = __builtin_amdgcn_permlane32_swap(__float_as_uint(ss), __float_as_uint(ss), false, false); ss = __uint_as_float(rr[0]) + __uint_as_float(rr[1]); }
    const float rinv = 1.0f / sqrtf(ss * (1.0f / 128.0f) + 1e-6f);
#pragma unroll
    for (int d0 = 0; d0 < 8; ++d0) { const f32x8 g = *reinterpret_cast<const f32x8*>(qgain + 16 * d0 + 8 * hi);
#pragma unroll
      for (int i = 0; i < 8; ++i) qf[d0][i] = qf[d0][i] * rinv * g[i]; }
    const int t = t0 + wid * QBLK + r32;
#pragma unroll
    for (int ax = 0; ax < 2; ++ax) { const int pos = ax ? (t & 63) : (t >> 6);
#pragma unroll
      for (int dd = 0; dd < 2; ++dd) {
        const float* tp = TA + ((size_t)pos * 32 + 16 * dd + 8 * hi) * 2; const f32x8 c0 = *reinterpret_cast<const f32x8*>(tp), c1 = *reinterpret_cast<const f32x8*>(tp + 8);
        const float cs[8] = {c0[0], c0[2], c0[4], c0[6], c1[0], c1[2], c1[4], c1[6]}, sn[8] = {c0[1], c0[3], c0[5], c0[7], c1[1], c1[3], c1[5], c1[7]};
#pragma unroll
        for (int i = 0; i < 8; ++i) { const float xf = qf[4 * ax + dd][i], xs = qf[4 * ax + dd + 2][i]; qf[4 * ax + dd][i] = xf * cs[i] - xs * sn[i]; qf[4 * ax + dd + 2][i] = xs * cs[i] + xf * sn[i]; } } }
#pragma unroll
    for (int d0 = 0; d0 < 8; ++d0) { u32x4 w = {cvtpk(qf[d0][0], qf[d0][1]), cvtpk(qf[d0][2], qf[d0][3]), cvtpk(qf[d0][4], qf[d0][5]), cvtpk(qf[d0][6], qf[d0][7])}; qr[d0] = *reinterpret_cast<bf16x8*>(&w); }
  }
  bf16* qo = Qb + (long)(wid * QBLK + r32) * LDQ + hi * 8;
#pragma unroll
  for (int d0 = 0; d0 < 8; ++d0) *reinterpret_cast<bf16x8*>(qo + d0 * 16) = qr[d0];
  asm volatile("s_waitcnt vmcnt(0)" ::: "memory");
  __builtin_amdgcn_fence(__ATOMIC_ACQUIRE, "agent");
  asm volatile("s_waitcnt vmcnt(0)" ::: "memory");
}
#undef KSWZ
#undef SBAR
}
namespace ret {
#define RET_LAS __attribute__((address_space(3)))
typedef unsigned short bf16_t;
typedef short bf16x8 __attribute__((ext_vector_type(8)));
typedef short s16x4 __attribute__((ext_vector_type(4)));
typedef float f32x4 __attribute__((ext_vector_type(4)));
typedef float f32x16 __attribute__((ext_vector_type(16)));
typedef float f32x2 __attribute__((ext_vector_type(2)));
typedef unsigned u32x4 __attribute__((ext_vector_type(4)));
typedef unsigned u32x2 __attribute__((ext_vector_type(2)));
constexpr int T = 32, NS = 72;
constexpr int QS = 520, KS = 544, VS = 288, PS = 80, YS = 528;
constexpr int Q_OFF = 0, K_OFF = T * QS, V_OFF = K_OFF + T * KS, VZ_OFF = V_OFF + T * VS, STG = VZ_OFF + T * VS;
constexpr int P_OFF = 2 * STG, YT_OFF = P_OFF + T * PS, YT_BYTES = T * YS, LDS_END = YT_OFF + 2 * YT_BYTES;
constexpr int LDQKV = 4096, LDY = 2048, SLR = 2304;
static_assert(STG % 16 == 0 && P_OFF % 16 == 0 && YT_OFF % 16 == 0 && K_OFF % 16 == 0 && V_OFF % 16 == 0 && VZ_OFF % 16 == 0, "LDS alignment");

__device__ __forceinline__ unsigned f2bf(float f) { unsigned u = __builtin_bit_cast(unsigned, f); return (u + 0x7fffu + ((u >> 16) & 1u)) >> 16; }
__device__ __forceinline__ unsigned pk2(float lo, float hi) { unsigned r; asm volatile("v_cvt_pk_bf16_f32 %0, %1, %2" : "=v"(r) : "v"(lo), "v"(hi)); return r; }
__device__ __forceinline__ float bflo(unsigned w) { return __builtin_bit_cast(float, w << 16); }
__device__ __forceinline__ float bfhi(unsigned w) { return __builtin_bit_cast(float, w & 0xffff0000u); }
template <int CTRL> __device__ __forceinline__ float dpp_f(float v) { return __builtin_bit_cast(float, __builtin_amdgcn_update_dpp(0, __builtin_bit_cast(int, v), CTRL, 0xF, 0xF, true)); }
template <int OFF> __device__ __forceinline__ s16x4 trr(unsigned base) { s16x4 r; asm volatile("ds_read_b64_tr_b16 %0, %1 offset:%2" : "=&v"(r) : "v"(base), "i"(OFF) : "memory"); return r; }
#define RET_LWAIT() do { asm volatile("s_waitcnt lgkmcnt(0)" ::: "memory"); __builtin_amdgcn_sched_barrier(0); } while (0)
#define RET_PK(L, H) (bf16x8){L[0], L[1], L[2], L[3], H[0], H[1], H[2], H[3]}
#define RET_MFMA16(a, b, c) __builtin_amdgcn_mfma_f32_16x16x32_bf16((a), (b), (c), 0, 0, 0)
#define RET_MFMA32(a, b, c) __builtin_amdgcn_mfma_f32_32x32x16_bf16((a), (b), (c), 0, 0, 0)
#define RET_BAR() asm volatile("s_waitcnt lgkmcnt(0)\n\ts_barrier" ::: "memory")
#define RET_SIDX(it_) (sweep ? (it_) : ((it_) < 8 ? 7 - (it_) : 79 - (it_)))

template <int VAR = 0> __device__ __forceinline__ void ret_item(RET_LAS unsigned char* lds, const bf16_t* __restrict__ qkv, bf16_t* __restrict__ Y, float* __restrict__ PSt, int bl, int h, int eq, float lgf, float lgb) {
    const int tid = threadIdx.x, w = __builtin_amdgcn_readfirstlane(tid >> 6), lane = tid & 63;
    const size_t rowbase = (size_t)bl * SLR;
    const unsigned ldsb = (unsigned)(uintptr_t)lds;

    for (int sweep = 0; sweep < 2; ++sweep) {
        const float lg2 = (sweep ? lgf : lgb) * 1.4426950408889634f;
        if (w < 4) {
            int lz = lane; asm volatile("" : "+v"(lz));
            const int cw = w, l32 = lz & 31, hh = lz >> 5, l16 = lz & 15, g16 = lz >> 4, q4 = l16 >> 2, p4 = l16 & 3;
            const float gam = __builtin_amdgcn_exp2f(lg2 * (float)T);
            const float xi = __builtin_amdgcn_exp2f(lg2 * (float)(sweep ? l32 + 1 : T - l32));
            const int cqh = cw >> 1, cqc = cw & 1;
            float pf[4];
#pragma unroll
            for (int i = 0; i < 4; ++i) { const int c = 16 * cqc + l16, cp = 16 * cqh + 4 * g16 + i, diff = sweep ? (c - cp) : (cp - c); pf[i] = diff >= 0 ? __builtin_amdgcn_exp2f(lg2 * (float)diff) : 0.f; }
            f32x16 S[8];
#pragma unroll
            for (int i = 0; i < 8; ++i)
#pragma unroll
                for (int r = 0; r < 16; ++r) S[i][r] = 0.f;
            RET_BAR();
            for (int it = 0; it < NS; ++it) {
                RET_LAS unsigned char* st = lds + (it & 1) * STG;
                const unsigned stb = ldsb + (it & 1) * STG;
                if (!(VAR & 4)) {
                    f32x4 pacc = (f32x4){0.f, 0.f, 0.f, 0.f};
#pragma unroll
                    for (int ks = 0; ks < 8; ++ks) {
                        const bf16x8 ak = *(const RET_LAS bf16x8*)(st + K_OFF + (16 * cqh + l16) * KS + (32 * ks + 8 * g16) * 2);
                        const u32x2 q0 = *(const RET_LAS u32x2*)(st + Q_OFF + (16 * cqc + l16) * QS + (32 * ks + 8 * g16) * 2), q1 = *(const RET_LAS u32x2*)(st + Q_OFF + (16 * cqc + l16) * QS + (32 * ks + 8 * g16) * 2 + 8);
                        u32x4 qq; qq.x = q0.x; qq.y = q0.y; qq.z = q1.x; qq.w = q1.y;
                        pacc = RET_MFMA16(ak, __builtin_bit_cast(bf16x8, qq), pacc); }
                    u32x2 o; o.x = pk2(pacc[0] * pf[0], pacc[1] * pf[1]); o.y = pk2(pacc[2] * pf[2], pacc[3] * pf[3]);
                    *(RET_LAS u32x2*)(lds + P_OFF + (16 * cqc + l16) * PS + (16 * cqh + 4 * g16) * 2) = o;
                }
                RET_BAR();
                if (!(VAR & 2)) {
                    f32x16 pv;
#pragma unroll
                    for (int r = 0; r < 16; ++r) pv[r] = 0.f;
#pragma unroll
                    for (int dt = 0; dt < 8; ++dt)
#pragma unroll
                        for (int s = 0; s < 2; ++s) {
                            u32x4 sa; sa.x = pk2(S[dt][8 * s + 0], S[dt][8 * s + 1]); sa.y = pk2(S[dt][8 * s + 2], S[dt][8 * s + 3]); sa.z = pk2(S[dt][8 * s + 4], S[dt][8 * s + 5]); sa.w = pk2(S[dt][8 * s + 6], S[dt][8 * s + 7]);
                            const u32x2 lo = *(const RET_LAS u32x2*)(st + Q_OFF + l32 * QS + (32 * dt + 16 * s + 4 * hh) * 2), hi = *(const RET_LAS u32x2*)(st + Q_OFF + l32 * QS + (32 * dt + 16 * s + 8 + 4 * hh) * 2);
                            u32x4 qq; qq.x = lo.x; qq.y = lo.y; qq.z = hi.x; qq.w = hi.y;
                            pv = RET_MFMA32(__builtin_bit_cast(bf16x8, sa), __builtin_bit_cast(bf16x8, qq), pv); }
                    pv = pv * xi;
                    { const unsigned a0 = stb + V_OFF + (8 * hh + q4) * VS + (32 * cw + 16 * (g16 & 1) + 4 * p4) * 2;
                      const s16x4 l0 = trr<0>(a0), h0 = trr<4 * VS>(a0), l1 = trr<16 * VS>(a0), h1 = trr<20 * VS>(a0);
                      const bf16x8 bp0 = *(const RET_LAS bf16x8*)(lds + P_OFF + l32 * PS + (8 * hh) * 2), bp1 = *(const RET_LAS bf16x8*)(lds + P_OFF + l32 * PS + (16 + 8 * hh) * 2);
                      RET_LWAIT();
                      pv = RET_MFMA32(RET_PK(l0, h0), bp0, pv); pv = RET_MFMA32(RET_PK(l1, h1), bp1, pv); }
                    RET_LAS unsigned char* yt = lds + YT_OFF + (it & 1) * YT_BYTES + l32 * YS + (32 * cw + 4 * hh) * 4;
#pragma unroll
                    for (int q = 0; q < 4; ++q) *(RET_LAS f32x4*)(yt + q * 32) = (f32x4){pv[4 * q], pv[4 * q + 1], pv[4 * q + 2], pv[4 * q + 3]};
                }
                if (!(VAR & 16)) {
                    const unsigned z0 = stb + VZ_OFF + (8 * hh + q4) * VS + (32 * cw + 16 * (g16 & 1) + 4 * p4) * 2;
                    const s16x4 zl0 = trr<0>(z0), zh0 = trr<4 * VS>(z0), zl1 = trr<16 * VS>(z0), zh1 = trr<20 * VS>(z0);
                    const unsigned k0 = stb + K_OFF + (8 * hh + q4) * KS + (16 * (g16 & 1) + 4 * p4) * 2;
#define RET_RD(dt, a, b, c, d) a = trr<64 * (dt)>(k0); b = trr<64 * (dt) + 4 * KS>(k0); c = trr<64 * (dt) + 16 * KS>(k0); d = trr<64 * (dt) + 20 * KS>(k0)
#define RET_WAIT4() do { asm volatile("s_waitcnt lgkmcnt(4)" ::: "memory"); __builtin_amdgcn_sched_barrier(0); } while (0)
#define RET_UP(dt, a, b, c, d) do { S[dt] = S[dt] * gam; S[dt] = RET_MFMA32(RET_PK(a, b), bz0, S[dt]); S[dt] = RET_MFMA32(RET_PK(c, d), bz1, S[dt]); __builtin_amdgcn_sched_barrier(0); } while (0)
                    s16x4 a0, a1, a2, a3, b0, b1, b2, b3;
                    RET_RD(0, a0, a1, a2, a3); RET_RD(1, b0, b1, b2, b3);
                    RET_WAIT4();
                    const bf16x8 bz0 = RET_PK(zl0, zh0), bz1 = RET_PK(zl1, zh1);
                    RET_UP(0, a0, a1, a2, a3); RET_RD(2, a0, a1, a2, a3); RET_WAIT4();
                    RET_UP(1, b0, b1, b2, b3); RET_RD(3, b0, b1, b2, b3); RET_WAIT4();
                    RET_UP(2, a0, a1, a2, a3); RET_RD(4, a0, a1, a2, a3); RET_WAIT4();
                    RET_UP(3, b0, b1, b2, b3); RET_RD(5, b0, b1, b2, b3); RET_WAIT4();
                    RET_UP(4, a0, a1, a2, a3); RET_RD(6, a0, a1, a2, a3); RET_WAIT4();
                    RET_UP(5, b0, b1, b2, b3); RET_RD(7, b0, b1, b2, b3); RET_WAIT4();
                    RET_UP(6, a0, a1, a2, a3); RET_LWAIT();
                    RET_UP(7, b0, b1, b2, b3);
#undef RET_RD
#undef RET_WAIT4
#undef RET_UP
                }
                RET_BAR();
            }
            RET_BAR();
        } else {
            int lt = tid - 256; asm volatile("" : "+v"(lt));
            const __amdgpu_buffer_rsrc_t srd = __builtin_amdgcn_make_buffer_rsrc((void*)qkv, (short)0, (int)((size_t)36864 * LDQKV * 2), 0x00020000);
            unsigned vq[4], vv[2];
#pragma unroll
            for (int i = 0; i < 4; ++i) { const int id = lt + 256 * i, row = id >> 5, ch = id & 31; vq[i] = (unsigned)(row * LDQKV + ch * 8) * 2u; }
#pragma unroll
            for (int i = 0; i < 2; ++i) { const int id = lt + 256 * i, row = id >> 4, ch = id & 15; vv[i] = (unsigned)(row * LDQKV + 2048 + ch * 8) * 2u; }
            const unsigned sq0 = (unsigned)((rowbase * LDQKV + h * 256) * 2), sv0 = (unsigned)((rowbase * LDQKV + h * 512 + eq * 128) * 2);
            RET_LAS unsigned char* lq[4]; RET_LAS unsigned char* lk[4]; RET_LAS unsigned char* lv[2];
#pragma unroll
            for (int i = 0; i < 4; ++i) { const int id = lt + 256 * i, row = id >> 5, ch = id & 31; lq[i] = lds + Q_OFF + row * QS + ch * 16; lk[i] = lds + K_OFF + row * KS + ch * 16; }
#pragma unroll
            for (int i = 0; i < 2; ++i) { const int id = lt + 256 * i, row = id >> 4, ch = id & 15; lv[i] = lds + V_OFF + row * VS + ch * 16; }
            float zz[2];
#pragma unroll
            for (int i = 0; i < 2; ++i) { const int row = (lt + 256 * i) >> 4; zz[i] = __builtin_amdgcn_exp2f(lg2 * (float)(sweep ? T - 1 - row : row)); }
            const int yc = lt >> 3, ye = (lt & 7) * 16;
            bf16_t* yg = Y + rowbase * LDY + h * 512 + eq * 128 + ye;
            u32x4 rq[3][4], rk[3][4], rv[3][2];
#define RET_LOAD(set_, sidx_) do { const unsigned so_ = (unsigned)(sidx_) * (unsigned)(T * LDQKV * 2); \
                _Pragma("unroll") for (int i = 0; i < 4; ++i) { \
                    rq[set_][i] = __builtin_bit_cast(u32x4, __builtin_amdgcn_raw_buffer_load_b128(srd, (int)vq[i], (int)(so_ + sq0), 0)); \
                    rk[set_][i] = __builtin_bit_cast(u32x4, __builtin_amdgcn_raw_buffer_load_b128(srd, (int)vq[i], (int)(so_ + sq0 + 2048u), 0)); } \
                _Pragma("unroll") for (int i = 0; i < 2; ++i) rv[set_][i] = __builtin_bit_cast(u32x4, __builtin_amdgcn_raw_buffer_load_b128(srd, (int)vv[i], (int)(so_ + sv0), 0)); } while (0)
#define RET_STAGE(set_, stage_) do { \
                _Pragma("unroll") for (int i = 0; i < 4; ++i) { \
                    *(RET_LAS u32x2*)(lq[i] + (stage_) * STG) = (u32x2){rq[set_][i].x, rq[set_][i].y}; *(RET_LAS u32x2*)(lq[i] + (stage_) * STG + 8) = (u32x2){rq[set_][i].z, rq[set_][i].w}; \
                    *(RET_LAS u32x4*)(lk[i] + (stage_) * STG) = rk[set_][i]; } \
                _Pragma("unroll") for (int i = 0; i < 2; ++i) { const float z = zz[i]; \
                    *(RET_LAS u32x4*)(lv[i] + (stage_) * STG) = rv[set_][i]; \
                    u32x4 o; o.x = pk2(bflo(rv[set_][i].x) * z, bfhi(rv[set_][i].x) * z); o.y = pk2(bflo(rv[set_][i].y) * z, bfhi(rv[set_][i].y) * z); \
                    o.z = pk2(bflo(rv[set_][i].z) * z, bfhi(rv[set_][i].z) * z); o.w = pk2(bflo(rv[set_][i].w) * z, bfhi(rv[set_][i].w) * z); \
                    *(RET_LAS u32x4*)(lv[i] + (stage_) * STG + (VZ_OFF - V_OFF)) = o; } } while (0)
#define RET_DRAIN(buf_, sidx_) do { const RET_LAS unsigned char* yp_ = lds + YT_OFF + (buf_) * YT_BYTES + yc * YS + ye * 4; \
                const f32x4 a0_ = *(const RET_LAS f32x4*)(yp_), a1_ = *(const RET_LAS f32x4*)(yp_ + 16), a2_ = *(const RET_LAS f32x4*)(yp_ + 32), a3_ = *(const RET_LAS f32x4*)(yp_ + 48); \
                float yv_[16] = {a0_[0], a0_[1], a0_[2], a0_[3], a1_[0], a1_[1], a1_[2], a1_[3], a2_[0], a2_[1], a2_[2], a2_[3], a3_[0], a3_[1], a3_[2], a3_[3]}; \
                bf16_t* gp_ = yg + ((size_t)(sidx_) * T + yc) * LDY; \
                if (sweep) { const u32x4 o0_ = yb0, o1_ = yb1; \
                    yv_[0] += bflo(o0_.x); yv_[1] += bfhi(o0_.x); yv_[2] += bflo(o0_.y); yv_[3] += bfhi(o0_.y); yv_[4] += bflo(o0_.z); yv_[5] += bfhi(o0_.z); yv_[6] += bflo(o0_.w); yv_[7] += bfhi(o0_.w); \
                    yv_[8] += bflo(o1_.x); yv_[9] += bfhi(o1_.x); yv_[10] += bflo(o1_.y); yv_[11] += bfhi(o1_.y); yv_[12] += bflo(o1_.z); yv_[13] += bfhi(o1_.z); yv_[14] += bflo(o1_.w); yv_[15] += bfhi(o1_.w); \
                    float s1_ = 0.f, s2_ = 0.f; \
                    _Pragma("unroll") for (int i = 0; i < 16; ++i) { s1_ += yv_[i]; s2_ += yv_[i] * yv_[i]; } \
                    s1_ += dpp_f<0xB1>(s1_); s2_ += dpp_f<0xB1>(s2_); s1_ += dpp_f<0x4E>(s1_); s2_ += dpp_f<0x4E>(s2_); s1_ += dpp_f<0x141>(s1_); s2_ += dpp_f<0x141>(s2_);     \
                    if ((lt & 7) == 0) *(f32x2*)(PSt + (((rowbase + (size_t)(sidx_) * T + yc) * 4 + h) * 4 + eq) * 2) = (f32x2){s1_, s2_}; } \
                u32x4 w0_, w1_; w0_.x = pk2(yv_[0], yv_[1]); w0_.y = pk2(yv_[2], yv_[3]); w0_.z = pk2(yv_[4], yv_[5]); w0_.w = pk2(yv_[6], yv_[7]); \
                w1_.x = pk2(yv_[8], yv_[9]); w1_.y = pk2(yv_[10], yv_[11]); w1_.z = pk2(yv_[12], yv_[13]); w1_.w = pk2(yv_[14], yv_[15]); \
                *(u32x4*)gp_ = w0_; *(u32x4*)(gp_ + 8) = w1_; } while (0)
            u32x4 yb0 = (u32x4){0u, 0u, 0u, 0u}, yb1 = (u32x4){0u, 0u, 0u, 0u};
#define RET_YPRE(sidx_) do { if (sweep) { const bf16_t* gq_ = yg + ((size_t)(sidx_) * T + yc) * LDY; yb0 = *(const u32x4*)gq_; yb1 = *(const u32x4*)(gq_ + 8); } } while (0)
            RET_LOAD(0, RET_SIDX(0)); RET_STAGE(0, 0); RET_LOAD(0, RET_SIDX(1)); RET_LOAD(1, RET_SIDX(2)); RET_LOAD(2, RET_SIDX(3));
            RET_BAR();
#define RET_LITER(it_, set_, stage_) do { \
                if (!(VAR & 1) && (it_) >= 1) RET_DRAIN(((it_) - 1) & 1, RET_SIDX((it_) - 1));     \
                if (!(VAR & 1)) RET_YPRE(RET_SIDX(it_));              \
                RET_BAR();                                      \
                if (!(VAR & 8) && (it_) + 1 < NS) RET_STAGE(set_, stage_);     \
                if (!(VAR & 8) && (it_) + 4 < NS) RET_LOAD(set_, RET_SIDX((it_) + 4)); \
                RET_BAR();                                      } while (0)
            for (int it = 0; it < NS; it += 6) { RET_LITER(it, 0, 1); RET_LITER(it + 1, 1, 0); RET_LITER(it + 2, 2, 1); RET_LITER(it + 3, 0, 0); RET_LITER(it + 4, 1, 1); RET_LITER(it + 5, 2, 0); }
#undef RET_LITER
            RET_DRAIN((NS - 1) & 1, RET_SIDX(NS - 1));
            RET_BAR();
#undef RET_LOAD
#undef RET_STAGE
#undef RET_DRAIN
#undef RET_YPRE
        }
        asm volatile("s_waitcnt vmcnt(0)" ::: "memory");
        __threadfence();
        __syncthreads();
    }
}
}
#ifndef DUP_ATT
#define DUP_ATT 0
#endif
#ifndef DUP_RET
#define DUP_RET 0
#endif
constexpr int NWAVES = 8, NTHR = 512;
constexpr int NB = 32, SEQ = 2048, DM = 1024, CTX = 256, SL = 2304;
constexpr int MROWS = NB * SL, HROWS = MROWS / 2;
constexpr int NMOD = 6 * DM;
constexpr int RET_IN = 6144, RET_QKV = 4096, RET_V = 2048;
constexpr int ATT_IN = 1536;
constexpr int NEXP = 32, EHID = 512;
constexpr int MAXTILES = 608, MAXSLOTS = MAXTILES * 256;
constexpr float NORM_EPS = 1e-6f, HEAD_EPS = 1e-5f;

constexpr size_t MiB = 1u << 20;
constexpr size_t WS_CTL = 0, CTL_ZERO_BYTES = 1 * MiB;
constexpr size_t WS_MODP = 1 * MiB;
constexpr size_t WS_DROW = 1 * MiB;
constexpr size_t WS_MOD = 14 * MiB;
constexpr size_t WS_TR = 16 * MiB;
constexpr size_t WS_TA = WS_TR + 64 * 64 * 8;
constexpr size_t WS_QKG = WS_TR + 64 * 64 * 8 + 64 * 32 * 8;
constexpr size_t WS_CT = 17 * MiB;
constexpr size_t WS_RT = 18 * MiB;
constexpr size_t WS_PS = 22 * MiB;
constexpr size_t WS_WE2 = 31 * MiB + 512 * 1024;
constexpr size_t WS_SROW = 21 * MiB + 65536;
constexpr size_t WS_TILE = 21 * MiB;
constexpr size_t WS_WIN = 32 * MiB, WS_WOUT = 44 * MiB, WS_WQKV = 48 * MiB, WS_WO = 51 * MiB;
constexpr size_t WS_WGU = 56 * MiB;
constexpr size_t WS_WD = 184 * MiB;
constexpr size_t WS_XC = 248 * MiB;
constexpr size_t WS_BIG = 280 * MiB;
constexpr size_t WS_H0 = WS_BIG;
constexpr size_t WS_QKV0 = WS_BIG + 144 * MiB;
constexpr size_t WS_Y0 = WS_BIG + 432 * MiB;
constexpr size_t WS_A2 = WS_QKV0;
constexpr size_t WS_H2_0 = WS_BIG;
constexpr size_t WS_AS = WS_BIG + 144 * MiB;
constexpr size_t WS_HD = WS_BIG + 448 * MiB;
constexpr size_t WS_YS = WS_AS;
constexpr size_t WS_H1 = WS_BIG;
constexpr size_t WS_QKV1 = WS_BIG + 144 * MiB;
constexpr size_t WS_AO = WS_BIG + 360 * MiB;
constexpr size_t WS_KC = WS_BIG + 648 * MiB;
constexpr size_t WS_VC = WS_BIG + 684 * MiB;
constexpr size_t WS_H2_1 = WS_BIG + 504 * MiB;
constexpr size_t WS_AS1 = WS_BIG + 144 * MiB;
constexpr size_t WS_HD1 = WS_BIG;
constexpr size_t WS_YS1 = WS_BIG + 416 * MiB;
constexpr size_t WS_END = 1000 * MiB;
constexpr int CW_TMO = 0, CW_CODE = 1;
constexpr int CW_BAR = 4096, BAR_STRIDE = 3584;
constexpr int MAX_LAUNCH = 40;
constexpr int CW_PCNT0 = 163840, CW_PCNT1 = 196608, CW_NEXT0 = 229376, CW_NEXT1 = 229440, CW_RTMO = 2;
static_assert((CW_BAR + MAX_LAUNCH * BAR_STRIDE) <= CW_PCNT0 && CW_PCNT0 + 288 * 64 <= CW_PCNT1 && CW_PCNT1 + 256 * 64 <= CW_NEXT0 && (CW_NEXT1 + 64) * 4 <= (int)CTL_ZERO_BYTES, "control words inside the memset");

constexpr int RING_BYTES = 155648;
constexpr int MISC_OFF = RING_BYTES;
constexpr int LDS_BYTES = 160 * 1024;
static_assert(ret::LDS_END <= RING_BYTES && (int)att::SHM_ATTN <= RING_BYTES && pg8::STAGE_BYTES <= RING_BYTES && MISC_OFF + 4096 <= LDS_BYTES, "LDS map");

#define GAS __attribute__((address_space(1)))
#define LAS __attribute__((address_space(3)))
typedef unsigned short bf16;
typedef unsigned v4u __attribute__((ext_vector_type(4)));
typedef unsigned v2u __attribute__((ext_vector_type(2)));
typedef float f32x4 __attribute__((ext_vector_type(4)));
typedef float f32x2 __attribute__((ext_vector_type(2)));
typedef GAS unsigned gu32;
#define RLX_AGENT __ATOMIC_RELAXED, __HIP_MEMORY_SCOPE_AGENT
#define LDS_WAIT() asm volatile("s_waitcnt lgkmcnt(0)" ::: "memory")
#define DI __device__ __forceinline__
DI unsigned f2bf(float f) { unsigned u = __builtin_bit_cast(unsigned, f); return (u + 0x7fffu + ((u >> 16) & 1u)) >> 16; }
DI unsigned pk2(float lo, float hi) { return f2bf(lo) | (f2bf(hi) << 16); }
DI float bflo(unsigned w) { return __builtin_bit_cast(float, w << 16); }
DI float bfhi(unsigned w) { return __builtin_bit_cast(float, w & 0xffff0000u); }
DI float silu_f(float x) { return x / (1.0f + __expf(-x)); }

#define XB_TMO      128
#define XB_XCNT(j)  (256  + 64 * (j))
#define XB_XSUB(j)  (1280 + 64 * (j))
#define XB_XGEN(j)  (2304 + 64 * (j))
#define XB_TOP      3328
#define XB_TOPGEN   3392
#define XCD_BAR_WORDS 3456
#define XB_SPIN_CAP (1u << 18)
#define LAS __attribute__((address_space(3)))

__device__ __forceinline__ unsigned xb_ld(unsigned* p)              { return __hip_atomic_load(p, __ATOMIC_RELAXED, __HIP_MEMORY_SCOPE_AGENT); }
__device__ __forceinline__ unsigned xb_add(unsigned* p, unsigned v) { return __hip_atomic_fetch_add(p, v, __ATOMIC_RELAXED, __HIP_MEMORY_SCOPE_AGENT); }
__device__ __forceinline__ unsigned xb_xcc_id() { return (unsigned)__builtin_amdgcn_s_getreg((3 << 11) | 20) & 0xFu; }
#define XB_SPIN(cond, bar) do { unsigned _sp = 0; while (cond) { __builtin_amdgcn_s_sleep(1); \
    if ((++_sp & 255u) == 0u) { if (xb_ld(&(bar)[XB_TMO])) break; if (_sp > XB_SPIN_CAP) { atomicAdd(&(bar)[XB_TMO], 1u); break; } } } } while (0)

struct XcdBarrier {
    unsigned* bar; unsigned x;
    volatile LAS unsigned* st;
};

__device__ __forceinline__ XcdBarrier xcd_barrier_post(unsigned* bar, volatile LAS unsigned* st) {
    XcdBarrier b; b.bar = bar; b.x = xb_xcc_id(); b.st = st;
    if (threadIdx.x == 0) (void)xb_add(&bar[XB_XCNT(b.x)], 1u);
    return b;
}
__device__ __forceinline__ void xcd_barrier_complete(unsigned* bar, unsigned x, unsigned& nloc, unsigned& nx) {
    const unsigned G = gridDim.x * gridDim.y * gridDim.z;
    unsigned sum, cnt, mine, sp = 0u;
    for (;;) {
        sum = 0u; cnt = 0u; mine = 0u;
#pragma unroll
        for (unsigned j = 0; j < 16; ++j) { const unsigned c = xb_ld(&bar[XB_XCNT(j)]); sum += c; cnt += (c > 0u) ? 1u : 0u; mine = (j == x) ? c : mine; }
        if (sum == G) break;
        __builtin_amdgcn_s_sleep(1);
        if ((++sp & 255u) == 0u) { if (xb_ld(&bar[XB_TMO])) break; if (sp > XB_SPIN_CAP) { atomicAdd(&bar[XB_TMO], 1u); break; } }
    }
    nloc = mine > 0u ? mine : 1u; nx = cnt > 0u ? cnt : 1u;
}

__device__ __forceinline__ void xcd_barrier(const XcdBarrier& b) {
    asm volatile("s_waitcnt vmcnt(0)" ::: "memory");
    __syncthreads();
    if (threadIdx.x == 0) {
        unsigned* bar = b.bar;
        __builtin_amdgcn_s_waitcnt(0);
        unsigned nloc = b.st[0], nx = b.st[1];
        if (nloc == 0u) { xcd_barrier_complete(bar, b.x, nloc, nx); b.st[0] = nloc; b.st[1] = nx; }
        const unsigned old = xb_add(&bar[XB_XSUB(b.x)], 1u);
        const unsigned gen = old / nloc;
        if (old + 1u == (gen + 1u) * nloc) {
            __builtin_amdgcn_fence(__ATOMIC_RELEASE, "agent");
            asm volatile("s_waitcnt vmcnt(0)" ::: "memory");
            const unsigned og = xb_add(&bar[XB_TOP], 1u);
            const unsigned tg = og / nx;
            if (og + 1u == (tg + 1u) * nx) xb_add(&bar[XB_TOPGEN], 1u);
            else XB_SPIN(xb_ld(&bar[XB_TOPGEN]) == tg, bar);
            __builtin_amdgcn_fence(__ATOMIC_ACQUIRE, "agent");
            xb_add(&bar[XB_XGEN(b.x)], 1u);
            asm volatile("s_waitcnt vmcnt(0)" ::: "memory");
        } else {
            XB_SPIN(xb_ld(&bar[XB_XGEN(b.x)]) == gen, bar);
            __builtin_amdgcn_fence(__ATOMIC_ACQUIRE, "agent");
            asm volatile("s_waitcnt vmcnt(0)" ::: "memory");
        }
    }
    __syncthreads();
}

template <int N> __device__ __forceinline__ void wave_sum_n(float (&v)[N]) {
#pragma unroll
    for (int o = 1; o < 64; o <<= 1) { float t[N];
#pragma unroll
        for (int i = 0; i < N; ++i) t[i] = __shfl_xor(v[i], o);
#pragma unroll
        for (int i = 0; i < N; ++i) v[i] += t[i]; }
}


struct Args { const float* in[22]; float* out; unsigned char* ws; int ph_lo, ph_hi, li, pad; };
#define CAS __attribute__((address_space(4)))
struct Frame {
    const CAS Args* ap;
    LAS unsigned char* lds;
    volatile LAS unsigned* MISC;
    gu32* ctl;
    int tid, lane, wave;
    int vcu, G;
    float* out; unsigned char* ws;
};
DI float wave_sum(float v) {
#pragma unroll
    for (int o = 1; o < 64; o <<= 1) v += __shfl_xor(v, o);
    return v;
}
template <int MODE = 0> __device__ __forceinline__ void p0_transpose_item(const float* W, int K, int N, bf16* WT, int row_off, LAS float* scr, int item, int lane) {
    const int nblk = N / 32, kb = item / nblk, nb = item % nblk, k0 = 64 * kb, n0 = 32 * nb;
#pragma unroll 32
    for (int i = 0; i < 32; ++i) { const int kk = 2 * i + (lane >> 5); scr[kk * 33 + (lane & 31)] = __builtin_nontemporal_load(W + (size_t)(k0 + kk) * N + n0 + (lane & 31)); }
    LDS_WAIT(); asm volatile("" ::: "memory");
    const int c = lane & 7;
#pragma unroll
    for (int j = 0; j < 4; ++j) { const int n = (lane >> 3) + 8 * j; const LAS float* s = scr + (8 * c) * 33 + n;
        v4u o; o.x = pk2(s[0 * 33], s[1 * 33]); o.y = pk2(s[2 * 33], s[3 * 33]); o.z = pk2(s[4 * 33], s[5 * 33]); o.w = pk2(s[6 * 33], s[7 * 33]);
        const int nn = n0 + n;
        const int drow = MODE == 1 ? ((nn >> 2) * 8 + (nn & 3) + row_off) : (MODE == 2 && nn < 2048) ? ((nn & ~127) + 2 * (nn & 63) + ((nn >> 6) & 1)) : (MODE == 3 && nn < 1280) ? ((nn & ~63) + 2 * (nn & 31) + ((nn >> 5) & 1)) : (row_off + nn);
        *(GAS v4u*)(WT + (size_t)drow * K + k0 + 8 * c) = o; }
    LDS_WAIT(); asm volatile("" ::: "memory");
}


DI const float* src_row0(const Frame& F, int r) { const int b = r / SL, s = r - b * SL; return s < CTX ? F.ap->in[2] + ((size_t)b * CTX + s) * DM : F.ap->in[0] + ((size_t)b * SEQ + (s - CTX)) * DM; }
DI float* xs_row(const Frame& F, int r) { const int b = r / SL, s = r - b * SL; return s < CTX ? (float*)(F.ws + WS_XC) + ((size_t)b * CTX + s) * DM : F.out + ((size_t)b * SEQ + (s - CTX)) * DM; }
DI const float* mod_row(const Frame& F, int layer, int r) { const int b = r / SL, s = r - b * SL; return (const float*)(F.ws + WS_MOD) + ((size_t)layer * 33 + (s < CTX ? 32 : b)) * NMOD; }

DI void ld_row(const float* p, int lane, f32x4 (&v)[4]) {
#pragma unroll
    for (int j = 0; j < 4; ++j) v[j] = __builtin_nontemporal_load((const f32x4*)(p + 4 * lane + 256 * j));
}
DI void st_row(float* p, int lane, const f32x4 (&v)[4]) {
#pragma unroll
    for (int j = 0; j < 4; ++j) __builtin_nontemporal_store(v[j], (f32x4*)(p + 4 * lane + 256 * j));
}
DI void st_row_bf16(bf16* p, int lane, const f32x4 (&v)[4]) {
#pragma unroll
    for (int j = 0; j < 4; ++j) { v2u o; o.x = pk2(v[j][0], v[j][1]); o.y = pk2(v[j][2], v[j][3]); *(v2u*)(p + 4 * lane + 256 * j) = o; }
}
DI void ld_row_bf16(const bf16* p, int lane, f32x4 (&v)[4]) {
#pragma unroll
    for (int j = 0; j < 4; ++j) { const v2u o = *(const v2u*)(p + 4 * lane + 256 * j); v[j] = (f32x4){bflo(o.x), bfhi(o.x), bflo(o.y), bfhi(o.y)}; }
}
DI float row_rinv(const f32x4 (&v)[4]) {
    float s = 0.f;
#pragma unroll
    for (int j = 0; j < 4; ++j) s += (v[j][0] * v[j][0] + v[j][1] * v[j][1]) + (v[j][2] * v[j][2] + v[j][3] * v[j][3]);
    return 1.0f / sqrtf(wave_sum(s) * (1.0f / DM) + NORM_EPS);
}
template <int NR> DI void rows_rinv(const f32x4 (&x)[NR][4], float (&rinv)[NR]) {
#pragma unroll
    for (int k = 0; k < NR; ++k) { float s = 0.f;
#pragma unroll
        for (int j = 0; j < 4; ++j) s += (x[k][j][0] * x[k][j][0] + x[k][j][1] * x[k][j][1]) + (x[k][j][2] * x[k][j][2] + x[k][j][3] * x[k][j][3]);
        rinv[k] = s; }
    wave_sum_n<NR>(rinv);
#pragma unroll
    for (int k = 0; k < NR; ++k) rinv[k] = 1.0f / sqrtf(rinv[k] * (1.0f / DM) + NORM_EPS);
}
struct ModVec { f32x4 sh[4], sc[4]; };
DI void modulate_apply(const f32x4 (&x)[4], float rinv, const ModVec& mv, f32x4 (&h)[4]) {
#pragma unroll
    for (int j = 0; j < 4; ++j) h[j] = x[j] * rinv * (mv.sc[j] + 1.0f) + mv.sh[j];
}
DI void ld_modvec(const float* __restrict__ mod, int sh_off, int lane, ModVec& mv) {
#pragma unroll
    for (int j = 0; j < 4; ++j) { mv.sh[j] = *(const f32x4*)(mod + sh_off + 4 * lane + 256 * j); mv.sc[j] = *(const f32x4*)(mod + sh_off + DM + 4 * lane + 256 * j); }
}
DI void modulate_vec(const f32x4 (&x)[4], const ModVec& mv, f32x4 (&h)[4]) {
    const float rinv = row_rinv(x);
#pragma unroll
    for (int j = 0; j < 4; ++j) h[j] = x[j] * rinv * (mv.sc[j] + 1.0f) + mv.sh[j];
}
template <int NR> DI void route_rows(const Frame& F, int layer, const f32x4 (&h)[NR][4], int lane, int (&e0)[NR], int (&e1)[NR], float (&g0)[NR], float (&g1)[NR]) {
    const LAS float* bg = (const LAS float*)(F.lds + 147456); const LAS float* be = bg + 4;
    const LAS float* Lg = (const LAS float*)(F.lds) + lane * 4;
    const LAS float* Le = (const LAS float*)(F.lds + 16384) + lane * 4;
    float gl[NR * 4];
#pragma unroll
    for (int i = 0; i < NR * 4; ++i) gl[i] = 0.f;
#pragma unroll
    for (int j = 0; j < 4; ++j)
#pragma unroll
        for (int i = 0; i < 4; ++i) { const f32x4 w = *(const LAS f32x4*)(Lg + (j * 4 + i) * 256);
#pragma unroll
            for (int k = 0; k < NR; ++k) { const float x = h[k][j][i]; gl[4 * k + 0] += x * w[0]; gl[4 * k + 1] += x * w[1]; gl[4 * k + 2] += x * w[2]; gl[4 * k + 3] += x * w[3]; } }
    wave_sum_n<NR * 4>(gl);
    int gi[NR]; float gp[NR];
#pragma unroll
    for (int k = 0; k < NR; ++k) { const float a0 = gl[4 * k] + bg[0], a1 = gl[4 * k + 1] + bg[1], a2 = gl[4 * k + 2] + bg[2], a3 = gl[4 * k + 3] + bg[3];
        int gidx = 0; float gm = a0; if (a1 > gm) { gm = a1; gidx = 1; } if (a2 > gm) { gm = a2; gidx = 2; } if (a3 > gm) { gm = a3; gidx = 3; }
        gp[k] = 1.0f / (__expf(a0 - gm) + __expf(a1 - gm) + __expf(a2 - gm) + __expf(a3 - gm)); gi[k] = __builtin_amdgcn_readfirstlane(gidx); }
    float el[NR * 8];
#pragma unroll
    for (int i = 0; i < NR * 8; ++i) el[i] = 0.f;
#pragma unroll
    for (int k = 0; k < NR; ++k) { const LAS float* wk = Le + gi[k] * 8192;
#pragma unroll
        for (int j = 0; j < 4; ++j)
#pragma unroll
            for (int i = 0; i < 4; ++i) { const f32x4 a = *(const LAS f32x4*)(wk + ((j * 4 + i) * 2) * 256), b = *(const LAS f32x4*)(wk + ((j * 4 + i) * 2 + 1) * 256); const float x = h[k][j][i];
                el[8 * k + 0] += x * a[0]; el[8 * k + 1] += x * a[1]; el[8 * k + 2] += x * a[2]; el[8 * k + 3] += x * a[3]; el[8 * k + 4] += x * b[0]; el[8 * k + 5] += x * b[1]; el[8 * k + 6] += x * b[2]; el[8 * k + 7] += x * b[3]; } }
    wave_sum_n<NR * 8>(el);
#pragma unroll
    for (int k = 0; k < NR; ++k) { float ev[8];
#pragma unroll
        for (int c = 0; c < 8; ++c) ev[c] = el[8 * k + c] + be[8 * gi[k] + c];
        int t1 = 0; float m1 = ev[0];
#pragma unroll
        for (int c = 1; c < 8; ++c) if (ev[c] > m1) { m1 = ev[c]; t1 = c; }
        int t2 = -1; float m2 = -3.0e38f;
#pragma unroll
        for (int c = 0; c < 8; ++c) if (c != t1 && ev[c] > m2) { m2 = ev[c]; t2 = c; }
        if (t2 < 0) t2 = (t1 + 1) & 7;
        const float p2 = __expf(m2 - m1), inv = 1.0f / (1.0f + p2);
        g0[k] = gp[k] * inv; g1[k] = gp[k] * p2 * inv; e0[k] = 8 * gi[k] + t1; e1[k] = 8 * gi[k] + t2; }
}

constexpr int P0I_WIN = 16 * 192, P0I_WOUT = 32 * 32, P0I_WQKV = 16 * 48, P0I_WO = 16 * 32, P0I_DENSE = P0I_WIN + P0I_WOUT + P0I_WQKV + P0I_WO, P0I_MOE1 = 768, P0_NITEMS = P0I_DENSE + 64 * P0I_MOE1;
struct P0Desc { const float* src; bf16* dst; int K, N, mode, row_off, item; };
DI P0Desc p0_decode(const Frame& F, int it) {
    int r = it;
    if (r < P0I_WIN) return P0Desc{F.ap->in[6], (bf16*)(F.ws + WS_WIN), DM, RET_IN, 2, 0, r}; r -= P0I_WIN;
    if (r < P0I_WOUT) return P0Desc{F.ap->in[7], (bf16*)(F.ws + WS_WOUT), RET_V, DM, 0, 0, r}; r -= P0I_WOUT;
    if (r < P0I_WQKV) return P0Desc{F.ap->in[10], (bf16*)(F.ws + WS_WQKV), DM, ATT_IN, 3, 0, r}; r -= P0I_WQKV;
    if (r < P0I_WO) return P0Desc{F.ap->in[11], (bf16*)(F.ws + WS_WO), DM, DM, 0, 0, r}; r -= P0I_WO;
    const int le = r / P0I_MOE1, rem = r - le * P0I_MOE1, which = rem >> 8, sub = rem & 255;
    if (which == 0) return P0Desc{F.ap->in[18] + (size_t)le * DM * EHID, (bf16*)(F.ws + WS_WGU) + (size_t)le * 1024 * 1024, DM, EHID, 1, 0, sub};
    if (which == 1) return P0Desc{F.ap->in[19] + (size_t)le * DM * EHID, (bf16*)(F.ws + WS_WGU) + (size_t)le * 1024 * 1024, DM, EHID, 1, 4, sub};
    return P0Desc{F.ap->in[20] + (size_t)le * EHID * DM, (bf16*)(F.ws + WS_WD) + (size_t)le * 1024 * 512, EHID, DM, 0, 0, sub};
}
DI void p0_issue(const P0Desc& d, int lane, f32x4 (&v)[8]) {
    const int nblk = d.N / 32, kb = d.item / nblk, nb = d.item - kb * nblk;
    const float* p = d.src + (size_t)(64 * kb + (lane >> 3)) * d.N + 32 * nb + 4 * (lane & 7);
#pragma unroll
    for (int i = 0; i < 8; ++i) v[i] = __builtin_nontemporal_load((const f32x4*)(p + (size_t)(8 * i) * d.N));
    __builtin_amdgcn_sched_barrier(0);
}
DI void p0_finish(const P0Desc& d, int lane, const f32x4 (&v)[8], LAS float* scr) {
    const int nblk = d.N / 32, kb = d.item / nblk, nb = d.item - kb * nblk, k0 = 64 * kb, n0 = 32 * nb;
#pragma unroll
    for (int i = 0; i < 8; ++i) { LAS float* w = scr + (8 * i + (lane >> 3)) * 33 + 4 * (lane & 7); w[0] = v[i][0]; w[1] = v[i][1]; w[2] = v[i][2]; w[3] = v[i][3]; }
    LDS_WAIT(); asm volatile("" ::: "memory");
    const int c = lane & 7;
#pragma unroll
    for (int j = 0; j < 4; ++j) { const int n = (lane >> 3) + 8 * j; const LAS float* s = scr + (8 * c) * 33 + n;
        v4u o; o.x = pk2(s[0 * 33], s[1 * 33]); o.y = pk2(s[2 * 33], s[3 * 33]); o.z = pk2(s[4 * 33], s[5 * 33]); o.w = pk2(s[6 * 33], s[7 * 33]);
        const int nn = n0 + n;
        const int drow = d.mode == 1 ? ((nn >> 2) * 8 + (nn & 3) + d.row_off) : (d.mode == 2 && nn < 2048) ? ((nn & ~127) + 2 * (nn & 63) + ((nn >> 6) & 1)) : (d.mode == 3 && nn < 1280) ? ((nn & ~63) + 2 * (nn & 31) + ((nn >> 5) & 1)) : (d.row_off + nn);
        *(GAS v4u*)(d.dst + (size_t)drow * d.K + k0 + 8 * c) = o; }
    LDS_WAIT(); asm volatile("" ::: "memory");
}
template <class Map> DI void p0_run(const Frame& F, int lo, int hi, int stride, Map map) {
    if (lo >= hi) return;
    LAS float* scr = (LAS float*)(F.lds + F.wave * 16384);
    f32x4 va[8], vb[8]; P0Desc da = p0_decode(F, map(lo)), db; int i = lo;
    p0_issue(da, F.lane, va);
    while (i + 2 * stride < hi) { db = p0_decode(F, map(i + stride)); p0_issue(db, F.lane, vb); p0_finish(da, F.lane, va, scr); da = p0_decode(F, map(i + 2 * stride)); p0_issue(da, F.lane, va); p0_finish(db, F.lane, vb, scr); i += 2 * stride; }
    if (i + stride < hi) { db = p0_decode(F, map(i + stride)); p0_issue(db, F.lane, vb); p0_finish(da, F.lane, va, scr); p0_finish(db, F.lane, vb, scr); } else p0_finish(da, F.lane, va, scr);
}
constexpr int P0D_L0 = P0I_WOUT + 32 * P0I_MOE1, P0D_DENSE1 = P0D_L0 + P0I_WQKV + P0I_WO, P0D_TOTAL = P0_NITEMS - P0I_WIN;
#ifndef BG3
#define BG3 4096
#endif
#ifndef BG5
#define BG5 4096
#endif
#ifndef BG7
#define BG7 8192
#endif
#ifndef BG8
#define BG8 19456
#endif
#ifndef BG15
#define BG15 4096
#endif
constexpr int BG3_LO = 0, BG5_LO = BG3_LO + BG3, BG7_LO = BG5_LO + BG5, BG8_LO = BG7_LO + BG7, BG_END = BG8_LO + BG8, BG15_LO = P0D_TOTAL - BG15;
static_assert(BG_END <= BG15_LO, "deferred list overrun"); static_assert(BG8 == 0 || BG8_LO >= P0I_WOUT, "W_out must be complete before the out projection (phase 8) starts");
static_assert(BG15 == 0 || BG15_LO >= P0D_DENSE1, "phase 15's chunk may hold layer-1 expert weights only");
DI int p0_deferred_phys(int d) {
    if (d < P0I_WOUT) return P0I_WIN + d;
    if (d < P0D_L0) return P0I_DENSE + (d - P0I_WOUT);
    if (d < P0D_DENSE1) return P0I_WIN + P0I_WOUT + (d - P0D_L0);
    return P0I_DENSE + 32 * P0I_MOE1 + (d - P0D_DENSE1);
}
DI void p0_background(Frame& F, int nwg, int d_lo, int d_hi) {
    const int first = nwg % F.G, n = F.G - first;
    if ((int)blockIdx.x < first || d_hi <= d_lo) return;
    __syncthreads();
    p0_run(F, d_lo + ((int)blockIdx.x - first) * NWAVES + F.wave, d_hi, n * NWAVES, [](int d) { return p0_deferred_phys(d); });
}
DI void p0_prologue(Frame& F) {
    LAS float* Ssil = (LAS float*)(F.lds + 131072);
    for (int vw = blockIdx.x; vw < 256; vw += F.G) {
        const int kq = vw & 7, grp = vw >> 3;
        __syncthreads();
        { float cv[9];
#pragma unroll
          for (int q = 0; q < 9; ++q) { const int idx = min(F.tid + q * NTHR, 33 * 128 - 1), m = idx >> 7, k = idx & 127; const float* src = m < 32 ? F.ap->in[1] + (size_t)m * DM : F.ap->in[3]; cv[q] = src[128 * kq + k]; }
#pragma unroll
          for (int q = 0; q < 9; ++q) { const int idx = F.tid + q * NTHR; if (idx < 33 * 128) Ssil[idx] = silu_f(cv[q]); } }
        __syncthreads();
        const int blk = grp * 8 + F.wave;
        if (blk < 192) {
            const int l = blk / 96, nb = blk - l * 96; const float* W = F.ap->in[4] + ((size_t)l * DM + 128 * kq) * NMOD + 64 * nb + F.lane;
            float acc[33];
#pragma unroll
            for (int m = 0; m < 33; ++m) acc[m] = 0.f;
            for (int k = 0; k < 128; k += 32) {
                float wv[32];
#pragma unroll
                for (int q = 0; q < 32; ++q) wv[q] = __builtin_nontemporal_load(W + (size_t)(k + q) * NMOD);
#pragma unroll
                for (int m = 0; m < 33; ++m) {
#pragma unroll
                    for (int q = 0; q < 32; q += 4) { const f32x4 s = *(const LAS f32x4*)(Ssil + m * 128 + k + q); acc[m] += (s[0] * wv[q] + s[1] * wv[q + 1]) + (s[2] * wv[q + 2] + s[3] * wv[q + 3]); } }
            }
            float* P = (float*)(F.ws + WS_MODP) + (((size_t)kq * 2 + l) * 33) * NMOD + 64 * nb + F.lane;
#pragma unroll
            for (int m = 0; m < 33; ++m) P[(size_t)m * NMOD] = acc[m];
        }
    }
    __syncthreads();
    { const int gt = blockIdx.x * NTHR + F.tid;
      if (gt < 64 * 64) { const int pos = gt >> 6, j = gt & 63; const float inv = __powf(10000.0f, -(float)j / 64.0f); float sn, cs; sincosf((float)pos * inv, &sn, &cs);
          ((f32x2*)(F.ws + WS_TR))[gt] = (f32x2){cs, sn}; }
      else if (gt < 64 * 64 + 64 * 32) { const int t = gt - 64 * 64, pos = t >> 5, j = t & 31; const float inv = __powf(10000.0f, -(float)j / 32.0f); float sn, cs; sincosf((float)pos * inv, &sn, &cs);
          ((f32x2*)(F.ws + WS_TA))[t] = (f32x2){cs, sn}; } }
    if (blockIdx.x == 0 && F.tid < 256) { const int which = F.tid >> 7, p = F.tid & 127, e = (p & ~63) + ((p & 63) >> 1) + 32 * (p & 1);
        ((float*)(F.ws + WS_QKG))[F.tid] = (which ? F.ap->in[13] : F.ap->in[12])[e]; }
    for (int i = blockIdx.x * NTHR + F.tid; i < 2 * DM * NEXP; i += F.G * NTHR) { const int c = i & 7, k = (i >> 3) & (DM - 1), gq = (i >> 13) & 3, l = i >> 15;
        ((float*)(F.ws + WS_WE2))[i] = F.ap->in[16][((size_t)l * DM + k) * NEXP + 8 * gq + c]; }
    p0_run(F, F.vcu * NWAVES + F.wave, P0I_WIN + (BG15_LO - BG_END), F.G * NWAVES, [](int it) { return it < P0I_WIN ? it : p0_deferred_phys(BG_END + it - P0I_WIN); });
}
DI void p0b_modreduce(Frame& F) {
    const float* P = (const float*)(F.ws + WS_MODP); float* M = (float*)(F.ws + WS_MOD);
    constexpr int NTOT = 2 * 33 * NMOD;
    for (int i0 = blockIdx.x * NTHR + F.tid; i0 < NTOT; i0 += 4 * F.G * NTHR) {
        float b[4], p[4][8];
#pragma unroll
        for (int q = 0; q < 4; ++q) { const int i = min(i0 + q * F.G * NTHR, NTOT - 1); const int l = i / (33 * NMOD), n = i % NMOD; b[q] = F.ap->in[5][(size_t)l * NMOD + n];
#pragma unroll
            for (int kq = 0; kq < 8; ++kq) p[q][kq] = P[(size_t)kq * NTOT + i]; }
#pragma unroll
        for (int q = 0; q < 4; ++q) { const int i = i0 + q * F.G * NTHR; float s = b[q];
#pragma unroll
            for (int kq = 0; kq < 8; ++kq) s += p[q][kq];
            if (i < NTOT) M[i] = s; }
    }
}
DI int seg_end(int r, int re) { const int s = r % SL; return min(re, r - s + (s < CTX ? CTX : SL)); }
DI void e1_modulate0(Frame& F) {
    const int gw = F.vcu * NWAVES + F.wave, NGW = F.G * NWAVES; bf16* __restrict__ H = (bf16*)(F.ws + WS_H0);
    constexpr int NR = 4;
    const int rpw = ((MROWS / NR + NGW - 1) / NGW) * NR, rb = gw * rpw, re = min(MROWS, rb + rpw);
    ModVec mv; f32x4 xa[NR][4], xb[NR][4];
    auto issue = [&](int r0, f32x4 (&x)[NR][4]) { const float* __restrict__ src = src_row0(F, r0);
#pragma unroll
        for (int k = 0; k < NR; ++k) ld_row(src + (size_t)k * DM, F.lane, x[k]);
        __builtin_amdgcn_sched_barrier(0); };
    auto finish = [&](int r0, f32x4 (&x)[NR][4]) {
        float rinv[NR]; rows_rinv<NR>(x, rinv);
#pragma unroll
        for (int k = 0; k < NR; ++k) { f32x4 h[4]; modulate_apply(x[k], rinv[k], mv, h); st_row_bf16(H + (size_t)(r0 + k) * DM, F.lane, h); } };
    for (int sb = rb; sb < re;) { const int se = seg_end(sb, re);
        ld_modvec(mod_row(F, 0, sb), 0, F.lane, mv);
        int r = sb; issue(r, xa); __builtin_amdgcn_s_waitcnt(0x0F70);
        while (r + 2 * NR < se) { issue(r + NR, xb); finish(r, xa); issue(r + 2 * NR, xa); finish(r + NR, xb); r += 2 * NR; }
        if (r + NR < se) { issue(r + NR, xb); finish(r, xa); finish(r + NR, xb); } else finish(r, xa);
        sb = se; }
}
DI void e_rope0(Frame& F, int hb) {
    const int gw = F.vcu * NWAVES + F.wave, NGW = F.G * NWAVES; bf16* Q = (bf16*)(F.ws + WS_QKV0); const f32x2* TR = (const f32x2*)(F.ws + WS_TR);
    const int lane = F.lane, j0 = 4 * (lane & 15); const bool second = (lane & 16) != 0, axis1 = lane >= 32;
    for (int rl = gw; rl < HROWS; rl += NGW) { const int r = hb * HROWS + rl, s = r % SL; bf16* row = Q + (size_t)rl * RET_QKV;
        if (s < CTX) {
#pragma unroll
            for (int hh = 0; hh < 4; ++hh) { v2u* p = (v2u*)(row + 1024 + hh * 256 + 4 * lane); const v2u o = *p; v2u w; w.x = pk2(bflo(o.x) * 0.0625f, bfhi(o.x) * 0.0625f); w.y = pk2(bflo(o.y) * 0.0625f, bfhi(o.y) * 0.0625f); *p = w; }
            continue; }
        const int t = s - CTX, pos = axis1 ? (t & 63) : (t >> 6);
        const f32x4 cs01 = *(const f32x4*)(TR + pos * 64 + j0), cs23 = *(const f32x4*)(TR + pos * 64 + j0 + 2);
        const float cs[4] = {cs01[0], cs01[2], cs23[0], cs23[2]}, sn[4] = {cs01[1], cs01[3], cs23[1], cs23[3]};
#pragma unroll
        for (int grp = 0; grp < 8; ++grp) {
            v2u* p = (v2u*)(row + grp * 256 + 4 * lane); const v2u o = *p; const float sc = grp >= 4 ? 0.0625f : 1.0f;
            const float x0 = bflo(o.x), x1 = bfhi(o.x), x2 = bflo(o.y), x3 = bfhi(o.y);
            const float y0 = __shfl_xor(x0, 16), y1 = __shfl_xor(x1, 16), y2 = __shfl_xor(x2, 16), y3 = __shfl_xor(x3, 16);
            const float sg = second ? 1.0f : -1.0f;
            v2u w; w.x = pk2((x0 * cs[0] + sg * y0 * sn[0]) * sc, (x1 * cs[1] + sg * y1 * sn[1]) * sc); w.y = pk2((x2 * cs[2] + sg * y2 * sn[2]) * sc, (x3 * cs[3] + sg * y3 * sn[3]) * sc);
            *p = w; }
    }
}
#ifndef RET_VAR
#define RET_VAR 0
#endif
#ifndef RET_MAINVAR
#define RET_MAINVAR 0
#endif
DI void ret_phase(Frame& F, int hb) {
    const bf16* qkv = (const bf16*)(F.ws + WS_QKV0); bf16* Y = (bf16*)(F.ws + WS_Y0) + (size_t)hb * HROWS * RET_V; float* PS = (float*)(F.ws + WS_PS) + (size_t)hb * HROWS * 32;
    if (RET_VAR) {
        for (int item = F.vcu; item < 16 * 4 * 4; item += F.G) { const int eq = item & 3, h = (item >> 2) & 3, bl = item >> 4;
            ret::ret_item<RET_VAR>(F.lds, qkv, Y, PS, bl, h, eq, F.ap->in[8][h], F.ap->in[9][h]); __syncthreads(); } }
    for (int it2 = F.vcu; it2 < 16 * 4 * 4 * (1 + DUP_RET); it2 += F.G) { const int item = it2 & 255; const int eq = item & 3, h = (item >> 2) & 3, bl = item >> 4;
        ret::ret_item<RET_MAINVAR>(F.lds, qkv, Y, PS, bl, h, eq, F.ap->in[8][h], F.ap->in[9][h]); __syncthreads(); }
}
DI void e_headnorm(Frame& F) {
    const int gw = F.vcu * NWAVES + F.wave, NGW = F.G * NWAVES; const bf16* Y = (const bf16*)(F.ws + WS_Y0); bf16* A2 = (bf16*)(F.ws + WS_A2);
    for (int rl = gw; rl < HROWS; rl += NGW) {
#pragma unroll
        for (int hh = 0; hh < 4; ++hh) { const v4u yv = *(const v4u*)(Y + (size_t)rl * RET_V + hh * 512 + 8 * F.lane); v4u* gp = (v4u*)(A2 + (size_t)rl * RET_V + hh * 512 + 8 * F.lane); const v4u gv = *gp;
            const float y[8] = {bflo(yv.x), bfhi(yv.x), bflo(yv.y), bfhi(yv.y), bflo(yv.z), bfhi(yv.z), bflo(yv.w), bfhi(yv.w)};
            const float g[8] = {bflo(gv.x), bfhi(gv.x), bflo(gv.y), bfhi(gv.y), bflo(gv.z), bfhi(gv.z), bflo(gv.w), bfhi(gv.w)};
            float s = 0.f;
#pragma unroll
            for (int i = 0; i < 8; ++i) s += y[i];
            const float mu = wave_sum(s) * (1.0f / 512.0f); float q = 0.f;
#pragma unroll
            for (int i = 0; i < 8; ++i) { const float d = y[i] - mu; q += d * d; }
            const float rstd = 1.0f / sqrtf(wave_sum(q) * (1.0f / 512.0f) + HEAD_EPS);
            float o[8];
#pragma unroll
            for (int i = 0; i < 8; ++i) o[i] = (y[i] - mu) * rstd * silu_f(g[i]);
            v4u w; w.x = pk2(o[0], o[1]); w.y = pk2(o[2], o[3]); w.z = pk2(o[4], o[5]); w.w = pk2(o[6], o[7]); *gp = w; }
    }
}
DI void route_weights_to_lds(Frame& F, int layer) {
    const float* __restrict__ wg = F.ap->in[14] + (size_t)layer * DM * 4; const float* __restrict__ we2 = (const float*)(F.ws + WS_WE2) + (size_t)layer * DM * NEXP;
    LAS float* Lg = (LAS float*)(F.lds); LAS float* Le = (LAS float*)(F.lds + 16384);
    __syncthreads();
    { f32x4 vg[2], ve[16];
#pragma unroll
      for (int q = 0; q < 2; ++q) vg[q] = *(const f32x4*)(wg + (size_t)(F.tid + q * NTHR) * 4);
#pragma unroll
      for (int q = 0; q < 16; ++q) ve[q] = *(const f32x4*)(we2 + (size_t)(F.tid + q * NTHR) * 4);
#pragma unroll
      for (int q = 0; q < 2; ++q) { const int k = F.tid + q * NTHR, j = k >> 8, ln = (k & 255) >> 2, i = k & 3; *(LAS f32x4*)(Lg + ((j * 4 + i) * 64 + ln) * 4) = vg[q]; }
#pragma unroll
      for (int q = 0; q < 16; ++q) { const int p = F.tid + q * NTHR, half = p & 1, k = (p >> 1) & (DM - 1), g = p >> 11; const int j = k >> 8, ln = (k & 255) >> 2, i = k & 3;
          *(LAS f32x4*)(Le + ((((g * 4 + j) * 4 + i) * 2 + half) * 64 + ln) * 4) = ve[q]; } }
    if (F.tid < 4) ((LAS float*)(F.lds + 147456))[F.tid] = F.ap->in[15][layer * 4 + F.tid]; else if (F.tid < 4 + NEXP) ((LAS float*)(F.lds + 147456))[F.tid] = F.ap->in[17][layer * NEXP + F.tid - 4];
    __syncthreads();
}
DI int vw_first_row(int row0, int vl, int rpv, bool skip_ctx) { return skip_ctx ? (vl >> 3) * SL + CTX + (vl & 7) * rpv : row0 + vl * rpv; }
DI void e_route(Frame& F, int layer, int row0, int nvw, int vw_base, int rpv, bf16* H2, bool skip_ctx) {
    int* RT = (int*)(F.ws + WS_RT); int* CT = (int*)(F.ws + WS_CT);
    route_weights_to_lds(F, layer);
    constexpr int NR = 2;
    const int rpw = rpv / NWAVES;
    for (int vl = blockIdx.x; vl < nvw; vl += F.G) {
        int mt = F.tid; asm volatile("" : "+v"(mt));
        __syncthreads();
        if (mt < 32) F.MISC[mt] = 0u;
        __syncthreads();
        const int wb = vw_first_row(row0, vl, rpv, skip_ctx) + F.wave * rpw, we = wb + rpw;
        f32x4 xa[NR][4], xb[NR][4]; ModVec mv;
        auto issue = [&](int rb, f32x4 (&x)[NR][4]) { const float* __restrict__ xp = xs_row(F, rb);
#pragma unroll
            for (int k = 0; k < NR; ++k) ld_row(xp + (size_t)k * DM, F.lane, x[k]);
            __builtin_amdgcn_sched_barrier(0); };
        auto finish = [&](int rb, f32x4 (&x)[NR][4]) {
            f32x4 h[NR][4]; float rinv[NR]; rows_rinv<NR>(x, rinv);
#pragma unroll
            for (int k = 0; k < NR; ++k) { modulate_apply(x[k], rinv[k], mv, h[k]); st_row_bf16(H2 + (size_t)(rb + k) * DM, F.lane, h[k]); }
            int e0[NR], e1[NR]; float g0[NR], g1[NR]; route_rows<NR>(F, layer, h, F.lane, e0, e1, g0, g1);
            if (F.lane == 0) {
#pragma unroll
                for (int k = 0; k < NR; ++k) { const int r0 = (int)__hip_atomic_fetch_add((LAS unsigned*)(F.MISC + e0[k]), 1u, __ATOMIC_RELAXED, __HIP_MEMORY_SCOPE_WORKGROUP);
                    const int r1 = (int)__hip_atomic_fetch_add((LAS unsigned*)(F.MISC + e1[k]), 1u, __ATOMIC_RELAXED, __HIP_MEMORY_SCOPE_WORKGROUP);
                    int* rt = RT + (size_t)(rb + k) * 8; rt[0] = e0[k]; rt[1] = e1[k]; rt[2] = r0; rt[3] = r1; rt[4] = __builtin_bit_cast(int, g0[k]); rt[5] = __builtin_bit_cast(int, g1[k]); } } };
        for (int sb = wb; sb < we;) { const int se = seg_end(sb, we);
            if (skip_ctx && (sb % SL) < CTX) { sb = se; continue; }
            ld_modvec(mod_row(F, layer, sb), 3 * DM, F.lane, mv);
            int r = sb; issue(r, xa); __builtin_amdgcn_s_waitcnt(0x0F70);
            while (r + 2 * NR < se) { issue(r + NR, xb); finish(r, xa); issue(r + 2 * NR, xa); finish(r + NR, xb); r += 2 * NR; }
            if (r + NR < se) { issue(r + NR, xb); finish(r, xa); finish(r + NR, xb); } else finish(r, xa);
            sb = se; }
        __syncthreads();
        if (mt < 32) CT[(size_t)(vw_base + vl) * 32 + mt] = (int)F.MISC[mt];
    }
}
DI void moe_prep(Frame& F, int nvw_total, int nvw, int vw_base, int row0, int rpv, bool skip_ctx) {
    int* RT = (int*)(F.ws + WS_RT); const int* CT = (const int*)(F.ws + WS_CT); int* TILE = (int*)(F.ws + WS_TILE); int* SROW = (int*)(F.ws + WS_SROW); int* DROW = (int*)(F.ws + WS_DROW);
    const int dummy = skip_ctx ? 2 * NB * SEQ : 2 * MROWS;
    LAS int* sP = (LAS int*)(F.lds);
    LAS int* sBase = (LAS int*)(F.lds + 2048);
    LAS int* sOff = (LAS int*)(F.lds + 2304);
    LAS int* sTot = (LAS int*)(F.lds + 2560);
    __syncthreads();
    { const int e = F.tid & 31, grp = F.tid >> 5, per = nvw_total / 16; int s = 0; for (int v = grp * per; v < (grp + 1) * per; ++v) s += CT[(size_t)v * 32 + e]; sP[grp * 32 + e] = s; }
    __syncthreads();
    if (F.tid == 0) { int base = 0;
        for (int e = 0; e < 32; ++e) { int tot = 0; for (int g = 0; g < 16; ++g) tot += sP[g * 32 + e]; sBase[e] = base; sTot[e] = tot; const int nt = (tot + 255) >> 8;
            base += nt << 8; }
        sTot[32] = base >> 8;
        if (blockIdx.x == 0) TILE[0] = base >> 8; }
    __syncthreads();
    if (blockIdx.x == 0) for (int t = F.tid; t < sTot[32]; t += NTHR) { int e = 0;
#pragma unroll
        for (int q = 1; q < 32; ++q) if ((sBase[q] >> 8) <= t && sTot[q] > 0) e = q;
        TILE[1 + t] = e; }
    for (int e = blockIdx.x; e < 32; e += F.G) {
        const int lo = sBase[e] + sTot[e], hi = sBase[e] + (((sTot[e] + 255) >> 8) << 8);
        for (int s = lo + F.tid; s < hi; s += NTHR) { SROW[s] = 0; DROW[s] = dummy; } }
    for (int vl = blockIdx.x; vl < nvw; vl += F.G) { const int v = vw_base + vl;
        __syncthreads();
        if (F.tid < 32) { const int per = nvw_total / 16, g0 = v / per; int s = sBase[F.tid];
            for (int g = 0; g < g0; ++g) s += sP[g * 32 + F.tid];
            int c[32];
#pragma unroll
            for (int q = 0; q < 32; ++q) { const int vv = g0 * per + q; c[q] = (q < per && vv < v) ? CT[(size_t)vv * 32 + F.tid] : 0; }
#pragma unroll
            for (int q = 0; q < 32; ++q) s += c[q];
            sOff[F.tid] = s; }
        __syncthreads();
        for (int k = F.tid; k < rpv; k += NTHR) { const int r = vw_first_row(row0, vl, rpv, skip_ctx) + k; const int s = r % SL;
            if (skip_ctx && s < CTX) continue;
            int* rt = RT + (size_t)r * 8; const int e0 = rt[0], e1 = rt[1], s0 = sOff[e0] + rt[2], s1 = sOff[e1] + rt[3];
            const int ti = skip_ctx ? (r / SL) * SEQ + (s - CTX) : r;
            SROW[s0] = r; SROW[s1] = r; DROW[s0] = 2 * ti; DROW[s1] = 2 * ti + 1; }
    }
    __syncthreads();
}
DI void e_silu(Frame& F, const bf16* GU, bf16* HD) {
    const int gw = F.vcu * NWAVES + F.wave, NGW = F.G * NWAVES; const int nrows = ((const int*)(F.ws + WS_TILE))[0] * 256;
    for (int r = gw; r < nrows; r += NGW) { const v4u gv = *(const v4u*)(GU + (size_t)r * DM + 8 * F.lane), uv = *(const v4u*)(GU + (size_t)r * DM + 512 + 8 * F.lane);
        v4u w; w.x = pk2(silu_f(bflo(gv.x)) * bflo(uv.x), silu_f(bfhi(gv.x)) * bfhi(uv.x)); w.y = pk2(silu_f(bflo(gv.y)) * bflo(uv.y), silu_f(bfhi(gv.y)) * bfhi(uv.y));
        w.z = pk2(silu_f(bflo(gv.z)) * bflo(uv.z), silu_f(bfhi(gv.z)) * bfhi(uv.z)); w.w = pk2(silu_f(bflo(gv.w)) * bflo(uv.w), silu_f(bfhi(gv.w)) * bfhi(uv.w));
        *(v4u*)(HD + (size_t)r * EHID + 8 * F.lane) = w; }
}
template <int NR> DI void moe_combine_rows(const Frame& F, int layer, int r0, const bf16* __restrict__ YS, int lane, f32x4 (&x)[NR][4]) {
    const int* __restrict__ RT = (const int*)(F.ws + WS_RT); size_t s0[NR], s1[NR]; float g0[NR], g1[NR];
    const float* __restrict__ xp = xs_row(F, r0);
#pragma unroll
    for (int k = 0; k < NR; ++k) { const int* rt = RT + (size_t)(r0 + k) * 8; const int r = r0 + k; const size_t ti = layer ? (size_t)(r / SL) * SEQ + (r % SL - CTX) : (size_t)r;
        s0[k] = 2 * ti; s1[k] = 2 * ti + 1; g0[k] = __builtin_bit_cast(float, rt[4]); g1[k] = __builtin_bit_cast(float, rt[5]); ld_row(xp + (size_t)k * DM, lane, x[k]); }
    v2u a[NR][4], b[NR][4]; f32x4 g2[4]; const float* __restrict__ mod = mod_row(F, layer, r0);
#pragma unroll
    for (int j = 0; j < 4; ++j) g2[j] = *(const f32x4*)(mod + 5 * DM + 4 * lane + 256 * j);
#pragma unroll
    for (int k = 0; k < NR; ++k)
#pragma unroll
        for (int j = 0; j < 4; ++j) { a[k][j] = *(const v2u*)(YS + (size_t)s0[k] * DM + 4 * lane + 256 * j); b[k][j] = *(const v2u*)(YS + (size_t)s1[k] * DM + 4 * lane + 256 * j); }
#pragma unroll
    for (int k = 0; k < NR; ++k)
#pragma unroll
        for (int j = 0; j < 4; ++j) {
            const f32x4 av = (f32x4){bflo(a[k][j].x), bfhi(a[k][j].x), bflo(a[k][j].y), bfhi(a[k][j].y)}, bv = (f32x4){bflo(b[k][j].x), bfhi(b[k][j].x), bflo(b[k][j].y), bfhi(b[k][j].y)};
            x[k][j] = x[k][j] + g2[j] * (av * g0[k] + bv * g1[k]); }
}
template <bool SHADOW = false> DI void e3_combine0(Frame& F) {
    const int gw = F.vcu * NWAVES + F.wave, NGW = F.G * NWAVES; const bf16* __restrict__ YS = (const bf16*)(F.ws + WS_YS); bf16* __restrict__ H1 = (bf16*)(F.ws + WS_H1);
    constexpr int NR = 4;
    for (int r0 = gw * NR; r0 < MROWS; r0 += NGW * NR) { f32x4 x[NR][4]; ModVec mv; ld_modvec(mod_row(F, 1, r0), 0, F.lane, mv); moe_combine_rows<NR>(F, 0, r0, YS, F.lane, x);
        float* __restrict__ xp = xs_row(F, r0); float rinv[NR]; rows_rinv<NR>(x, rinv);
#pragma unroll
        for (int k = 0; k < NR; ++k) { f32x4 h[4]; if (!SHADOW) st_row(xp + (size_t)k * DM, F.lane, x[k]); modulate_apply(x[k], rinv[k], mv, h); st_row_bf16(H1 + (size_t)(r0 + k) * DM, F.lane, h); } }
}
DI void e4_qknorm(Frame& F) {
    const int gw = F.vcu * NWAVES + F.wave, NGW = F.G * NWAVES; bf16* Q = (bf16*)(F.ws + WS_QKV1); const f32x2* TA = (const f32x2*)(F.ws + WS_TA);
    const int lane = F.lane, j0 = 2 * (lane & 15); const bool second = (lane & 16) != 0, axis1 = lane >= 32;
    const f32x2 kg = *(const f32x2*)(F.ap->in[13] + 2 * lane);
    constexpr int NR = 4;
    for (int r0 = gw * NR; r0 < MROWS; r0 += NGW * NR) {
        const int s0 = r0 % SL; const bool ctx = s0 < CTX; const float sg = second ? 1.0f : -1.0f;
        unsigned o[2 * NR]; float ss[2 * NR];
#pragma unroll
        for (int k = 0; k < NR; ++k)
#pragma unroll
            for (int hh = 0; hh < 2; ++hh) { o[2 * k + hh] = *(const unsigned*)(Q + (size_t)(r0 + k) * ATT_IN + (8 + hh) * 128 + 2 * lane); ss[2 * k + hh] = bflo(o[2 * k + hh]) * bflo(o[2 * k + hh]) + bfhi(o[2 * k + hh]) * bfhi(o[2 * k + hh]); }
        wave_sum_n<2 * NR>(ss);
        float x0[2 * NR], x1[2 * NR];
#pragma unroll
        for (int i = 0; i < 2 * NR; ++i) { const float rinv = 1.0f / sqrtf(ss[i] * (1.0f / 128.0f) + NORM_EPS); x0[i] = bflo(o[i]) * rinv * kg[0]; x1[i] = bfhi(o[i]) * rinv * kg[1]; }
        if (!ctx) {
#pragma unroll
            for (int k = 0; k < NR; ++k) { const int t = s0 + k - CTX, pos = axis1 ? (t & 63) : (t >> 6); const f32x4 cs = *(const f32x4*)(TA + pos * 32 + j0);
#pragma unroll
                for (int hh = 0; hh < 2; ++hh) { const int i = 2 * k + hh; const float y0 = __shfl_xor(x0[i], 16), y1 = __shfl_xor(x1[i], 16);
                    x0[i] = x0[i] * cs[0] + sg * y0 * cs[1]; x1[i] = x1[i] * cs[2] + sg * y1 * cs[3]; } } }
#pragma unroll
        for (int k = 0; k < NR; ++k)
#pragma unroll
            for (int hh = 0; hh < 2; ++hh) *(unsigned*)(Q + (size_t)(r0 + k) * ATT_IN + (8 + hh) * 128 + 2 * lane) = pk2(x0[2 * k + hh], x1[2 * k + hh]);
    }
}
DI void att_phase(Frame& F) {
    const bf16* QKV = (const bf16*)(F.ws + WS_QKV1); bf16* AO = (bf16*)(F.ws + WS_AO);
    for (int u = F.vcu; u < NB * 8 * 8; u += F.G) { const int qb = u & 7, hq = (u >> 3) & 7, b = u >> 6, kvh = hq >> 2;
        const size_t qrow = (size_t)b * SL + CTX + 256 * qb, krow = (size_t)b * SL;
        att::attn_dense_body<att::bf16>(QKV + qrow * ATT_IN + hq * 128, QKV + krow * ATT_IN + 1024 + kvh * 128, QKV + krow * ATT_IN + 1280 + kvh * 128, AO + qrow * DM + hq * 128, SL, (char*)F.lds);
        __syncthreads(); }
}
template <bool SHADOW = false> DI void e6_final(Frame& F) {
    const int gw = F.vcu * NWAVES + F.wave, NGW = F.G * NWAVES; const bf16* __restrict__ YS = (const bf16*)(F.ws + WS_YS1);
    constexpr int NR = 4;
    for (int r0 = gw * NR; r0 < MROWS; r0 += NGW * NR) { if (r0 % SL < CTX) continue;
        f32x4 x[NR][4], fg[4];
#pragma unroll
        for (int j = 0; j < 4; ++j) fg[j] = *(const f32x4*)(F.ap->in[21] + 4 * F.lane + 256 * j);
        moe_combine_rows<NR>(F, 1, r0, YS, F.lane, x);
        float* __restrict__ xp = xs_row(F, r0); float rinv[NR]; rows_rinv<NR>(x, rinv);
#pragma unroll
        for (int k = 0; k < NR; ++k) {
#pragma unroll
            for (int j = 0; j < 4; ++j) x[k][j] = x[k][j] * rinv[k] * fg[j];
            if (!SHADOW) st_row(xp + (size_t)k * DM, F.lane, x[k]); else if (x[k][0][0] == 123456.789f) st_row(xp + (size_t)k * DM, F.lane, x[k]); } }
}
#ifndef DUP_E3
#define DUP_E3 0
#endif
#ifndef DUP_E6
#define DUP_E6 0
#endif
#ifndef DUP_BAR
#define DUP_BAR 0
#endif
#ifndef DUP_P0
#define DUP_P0 0
#endif
#ifndef DUP_E1
#define DUP_E1 0
#endif
#ifndef DUP_RT
#define DUP_RT 0
#endif
#ifndef DUP_PREP
#define DUP_PREP 0
#endif
#ifndef DUP_RET
#define DUP_RET 0
#endif
#ifndef DUP_ATT
#define DUP_ATT 0
#endif
#ifndef DUP_G1
#define DUP_G1 0
#endif
#ifndef DUP_GG
#define DUP_GG 0
#endif
#ifndef DUP_GO
#define DUP_GO 0
#endif
#ifndef DUP_MG1
#define DUP_MG1 0
#endif
#ifndef DUP_MG2
#define DUP_MG2 0
#endif
#ifndef DUP_GQ
#define DUP_GQ 0
#endif
#ifndef DUP_GA
#define DUP_GA 0
#endif
#ifndef EN_P0
#define EN_P0 1
#endif
#ifndef EN_P0B
#define EN_P0B 1
#endif
#ifndef EN_E1
#define EN_E1 1
#endif
#ifndef EN_G1
#define EN_G1 1
#endif
#ifndef EN_ROPE
#define EN_ROPE 1
#endif
#ifndef EN_RET
#define EN_RET 1
#endif
#ifndef EN_GG
#define EN_GG 1
#endif
#ifndef EN_HN
#define EN_HN 1
#endif
#ifndef EN_GO
#define EN_GO 1
#endif
#ifndef EN_E2
#define EN_E2 1
#endif
#ifndef EN_PREP
#define EN_PREP 1
#endif
#ifndef EN_MG1
#define EN_MG1 1
#endif
#ifndef EN_SILU
#define EN_SILU 1
#endif
#ifndef EN_MG2
#define EN_MG2 1
#endif
#ifndef EN_E3
#define EN_E3 1
#endif
#ifndef EN_GQ
#define EN_GQ 1
#endif
#ifndef EN_E4
#define EN_E4 1
#endif
#ifndef EN_ATT
#define EN_ATT 1
#endif
#ifndef EN_GA
#define EN_GA 1
#endif
#ifndef EN_E5
#define EN_E5 1
#endif
#ifndef EN_E6
#define EN_E6 1
#endif
#ifndef STAG_TICKS
#define STAG_TICKS 0
#endif
DI void phase_stagger() { const int grp = ((int)blockIdx.x >> 3) & 3; if (STAG_TICKS == 0 || grp == 0) return;
    const unsigned long long t0 = __builtin_amdgcn_s_memrealtime(); while (__builtin_amdgcn_s_memrealtime() - t0 < (unsigned long long)(grp * STAG_TICKS)) __builtin_amdgcn_s_sleep(8); }
DI bool prb_enter(const Frame& F, int k) { if (PROBE_PHASE == k && blockIdx.x == 0 && F.wave == 0) { volatile LAS unsigned* w = PRB_W(F.lds); w[0] = 1u; w[1] = (unsigned)__builtin_amdgcn_s_memrealtime(); } return true; }
DI void prb_exit(const Frame& F) { if (PROBE_PHASE >= 0 && blockIdx.x == 0 && F.wave == 0) { volatile LAS unsigned* w = PRB_W(F.lds); if (w[0]) { if (PROBE_KIND == 0) w[2] += (unsigned)__builtin_amdgcn_s_memrealtime() - w[1]; w[0] = 0u; } } }
#ifndef MK_PER_PHASE
#define MK_PER_PHASE 0
#endif
constexpr int NPH = 25;

#define MOE_BLOCK(layer_, pb_, NVT_, RPV_, H2_, AS_, HD_, YS_, SKIP_) \
    if (EN_PREP && IN((pb_) + 0)) { moe_prep(F, NVT_, NVT_, 0, 0, RPV_, SKIP_); if (BOTH((pb_) + 0)) GRID_BAR(); } \
    if (EN_MG1 && IN((pb_) + 1)) { pg8::Gemm g{(const bf16*)(ws + (H2_)), (const bf16*)(ws + WS_WGU) + (size_t)(layer_) * 32 * 1024 * 1024, MAXSLOTS, 1024, 1024, (const int*)(ws + WS_SROW)}; pg8::GroupedOrder S; S.init((const int*)(ws + WS_TILE), F.G, F.vcu); \
        pg8::EpiSwiGLU E{(bf16*)(ws + (HD_)), 512, 3}; pg8::gemm_phase<pg8::EpiSwiGLU, pg8::GroupedOrder, true, true, true>(F.lds, g, S, E); if (DUP_MG1) { pg8::gemm_phase<pg8::EpiSwiGLU, pg8::GroupedOrder, true, true, true>(F.lds, g, S, E); } if (BOTH((pb_) + 1)) GRID_BAR(); } \
    if (EN_MG2 && IN((pb_) + 3)) { pg8::Gemm g{(const bf16*)(ws + (HD_)), (const bf16*)(ws + WS_WD) + (size_t)(layer_) * 32 * 1024 * 512, MAXSLOTS, 1024, 512}; pg8::GroupedOrder S; S.init((const int*)(ws + WS_TILE), F.G, F.vcu); \
        pg8::EpiScatterBf16 E{(bf16*)(ws + (YS_)), (const int*)(ws + WS_DROW), 3}; pg8::gemm_phase<pg8::EpiScatterBf16, pg8::GroupedOrder, true, true>(F.lds, g, S, E); if (DUP_MG2) { pg8::gemm_phase<pg8::EpiScatterBf16, pg8::GroupedOrder, true, true>(F.lds, g, S, E); } if (BOTH((pb_) + 3)) GRID_BAR(); }

#define LAYER0_QKV_RET(hb, pb) \
        if (EN_G1 && IN(pb + 0)) { \
            pg8::Gemm g{(const bf16*)(ws + WS_H0) + (size_t)(hb) * HROWS * DM, (const bf16*)(ws + WS_WIN), HROWS, RET_QKV, DM}; pg8::StaticOrder S; S.init(HROWS, RET_QKV, F.G, (int)blockIdx.x); \
            pg8::EpiRopeQKV E{(bf16*)(ws + WS_QKV0), (const float*)(ws + WS_TR), hb * 144}; pg8::gemm_phase<pg8::EpiRopeQKV, pg8::StaticOrder, true, true>(F.lds, g, S, E); if (DUP_G1) { pg8::gemm_phase<pg8::EpiRopeQKV, pg8::StaticOrder, true, true>(F.lds, g, S, E); } \
            if (hb == 0) p0_background(F, S.nwg, BG3_LO, BG3_LO + BG3); else p0_background(F, S.nwg, BG5_LO, BG5_LO + BG5); \
            if (BOTH(pb + 0)) GRID_BAR(); } \
        if (EN_RET && IN(pb + 1)) { ret_phase(F, hb); if (BOTH(pb + 1)) GRID_BAR(); }
__global__ void __launch_bounds__(NTHR, 2) mk_fwd(Args args) {
    extern __shared__ __attribute__((aligned(16))) unsigned char lds_raw[];
    Frame F;
    F.lds = (LAS unsigned char*)lds_raw;
    F.MISC = (volatile LAS unsigned*)(F.lds + MISC_OFF);
    F.tid = threadIdx.x; F.lane = F.tid & 63; F.wave = __builtin_amdgcn_readfirstlane(F.tid >> 6);
    F.G = gridDim.x; { const int bx = blockIdx.x; F.vcu = (F.G % 8 == 0) ? (bx % 8) * (F.G / 8) + bx / 8 : bx; }
    unsigned char* ws = args.ws; F.ws = ws; F.out = args.out;
    F.ap = (const CAS Args*)__builtin_amdgcn_kernarg_segment_ptr();
    F.ctl = (gu32*)(ws + WS_CTL);
    for (int u = F.tid; u < (LDS_BYTES - MISC_OFF) / 4; u += NTHR) ((LAS unsigned*)(F.lds + MISC_OFF))[u] = 0u;
    __syncthreads();
    const int lo = args.ph_lo, hi = args.ph_hi;
    XcdBarrier bar; bar.bar = (unsigned*)(F.ctl + CW_BAR) + args.li * BAR_STRIDE; bar.x = 0; bar.st = nullptr;
    if (hi - lo > 1) bar = xcd_barrier_post((unsigned*)(F.ctl + CW_BAR) + args.li * BAR_STRIDE, F.MISC + 64);
#define INR(k) (lo <= (k) && (k) < hi)
#define IN(k) (INR(k) && prb_enter(F, (k)))
#define BOTH(k) (INR(k) && INR((k) + 1))
#define GRID_BAR() do { xcd_barrier(bar); prb_exit(F); } while (0)

    if (EN_P0 && IN(0)) { p0_prologue(F); if (DUP_P0) p0_prologue(F); if (BOTH(0)) GRID_BAR(); }
    if (EN_P0B && IN(1)) { p0b_modreduce(F); if (BOTH(1)) GRID_BAR(); }

    if (EN_E1 && IN(2)) { e1_modulate0(F); if (BOTH(2)) GRID_BAR(); }
    LAYER0_QKV_RET(0, 3)
    LAYER0_QKV_RET(1, 5)
    if (EN_GG && IN(7)) {
        pg8::Gemm g{(const bf16*)(ws + WS_H0), (const bf16*)(ws + WS_WIN) + (size_t)RET_QKV * DM, MROWS, RET_V, DM}; pg8::StaticOrder S; S.init(MROWS, RET_V, F.G, (int)blockIdx.x);
        pg8::EpiHeadGate E{(const bf16*)(ws + WS_Y0), (const float*)(ws + WS_PS), (bf16*)(ws + WS_A2)}; pg8::gemm_phase<pg8::EpiHeadGate, pg8::StaticOrder, true, true>(F.lds, g, S, E); if (DUP_GG) { pg8::gemm_phase<pg8::EpiHeadGate, pg8::StaticOrder, true, true>(F.lds, g, S, E); }
        p0_background(F, S.nwg, BG7_LO, BG7_LO + BG7);
        if (BOTH(7)) GRID_BAR(); }
    if (EN_GO && IN(8)) {
        pg8::Gemm g{(const bf16*)(ws + WS_A2), (const bf16*)(ws + WS_WOUT), MROWS, DM, RET_V}; pg8::StaticOrder S; S.init(MROWS, DM, F.G, (int)blockIdx.x);
        pg8::EpiResid E{F.ap->in[0], F.ap->in[2], F.out, (float*)(ws + WS_XC), (const float*)(ws + WS_MOD), 2 * DM, 0}; pg8::gemm_phase<pg8::EpiResid, pg8::StaticOrder, true, true>(F.lds, g, S, E); if (DUP_GO) { pg8::gemm_phase<pg8::EpiResid, pg8::StaticOrder, true, true>(F.lds, g, S, E); }
        p0_background(F, S.nwg, BG8_LO, BG8_LO + BG8);
        if (BOTH(8)) GRID_BAR(); }
    if (EN_E2 && IN(9)) { e_route(F, 0, 0, 512, 0, 144, (bf16*)(ws + WS_H2_0), false); if (DUP_RT) e_route(F, 0, 0, 512, 0, 144, (bf16*)(ws + WS_H2_0), false); if (BOTH(9)) GRID_BAR(); }
    MOE_BLOCK(0, 10, 512, 144, WS_H2_0, WS_AS, WS_HD, WS_YS, false)
    if (EN_E3 && IN(14)) { if (DUP_E3) e3_combine0<true>(F); e3_combine0(F); if (BOTH(14)) GRID_BAR(); }

    if (EN_GQ && IN(15)) {
        pg8::Gemm g{(const bf16*)(ws + WS_H1), (const bf16*)(ws + WS_WQKV), MROWS, ATT_IN, DM}; pg8::StaticOrder S; S.init(MROWS, ATT_IN, F.G, (int)blockIdx.x);
        pg8::EpiQKNorm E{(bf16*)(ws + WS_QKV1), (const float*)(ws + WS_TA), (const float*)(ws + WS_QKG), (const float*)(ws + WS_QKG) + 128, (PG8_LAS float*)(F.lds + 131072)}; pg8::gemm_phase<pg8::EpiQKNorm, pg8::StaticOrder, true, true>(F.lds, g, S, E);
        p0_background(F, S.nwg, BG15_LO, BG15_LO + BG15);
        if (BOTH(15)) GRID_BAR(); }
    if (EN_ATT && IN(17)) { att_phase(F); if (BOTH(17)) GRID_BAR(); }
    if (EN_GA && IN(18)) {
        pg8::Gemm g{(const bf16*)(ws + WS_AO), (const bf16*)(ws + WS_WO), MROWS, DM, DM}; pg8::LatentOrder S; S.init(F.G, F.vcu);
        pg8::EpiResid E{F.out, (const float*)(ws + WS_XC), F.out, (float*)(ws + WS_XC), (const float*)(ws + WS_MOD) + (size_t)33 * NMOD, 2 * DM, 0}; pg8::gemm_phase<pg8::EpiResid, pg8::LatentOrder, true, true>(F.lds, g, S, E);
        if (BOTH(18)) GRID_BAR(); }
    if (EN_E5 && IN(19)) { e_route(F, 1, 0, 256, 0, 256, (bf16*)(ws + WS_H2_1), true); if (BOTH(19)) GRID_BAR(); }
    MOE_BLOCK(1, 20, 256, 256, WS_H2_1, WS_AS1, WS_HD1, WS_YS1, true)
    if (DUP_BAR && hi - lo > 1) { for (int i = 0; i < 20 * DUP_BAR; ++i) GRID_BAR(); }
    if (EN_E6 && IN(24)) { if (DUP_E6) e6_final<true>(F); e6_final(F); }
    if (PROBE_PHASE >= 0 && blockIdx.x == 0 && F.wave == 0) { volatile LAS unsigned* w = PRB_W(F.lds); if (w[0] && PROBE_KIND == 0) w[2] += (unsigned)__builtin_amdgcn_s_memrealtime() - w[1];
        const unsigned long long t0 = __builtin_amdgcn_s_memrealtime(), ticks = (unsigned long long)w[2] * PROBE_AMP; while (__builtin_amdgcn_s_memrealtime() - t0 < ticks) __builtin_amdgcn_s_sleep(32); }
#undef IN
#undef INR
#undef BOTH
#undef GRID_BAR
}

extern "C" void kernel_launch(void* const* d_in, const int* in_sizes, int n_in, void* d_out, int out_size, void* d_ws, size_t ws_size, hipStream_t stream) {
    static int grid = 0;
    if (grid == 0) {
        if (n_in != 22 || out_size != NB * SEQ * DM || ws_size < WS_END) { fprintf(stderr, "kernel_launch: unexpected shapes: n_in %d out %d ws %zu (need %zu)\n", n_in, out_size, ws_size, (size_t)WS_END); grid = -1; return; }
        int dev = 0, cus = 0, per_cu = 0;
        if (hipGetDevice(&dev) != hipSuccess || hipDeviceGetAttribute(&cus, hipDeviceAttributeMultiprocessorCount, dev) != hipSuccess) { grid = -1; return; }
        if (hipFuncSetAttribute((const void*)mk_fwd, hipFuncAttributeMaxDynamicSharedMemorySize, LDS_BYTES) != hipSuccess) { fprintf(stderr, "kernel_launch: hipFuncSetAttribute failed\n"); grid = -1; return; }
        if (hipOccupancyMaxActiveBlocksPerMultiprocessor(&per_cu, (const void*)mk_fwd, NTHR, LDS_BYTES) != hipSuccess || per_cu < 1) fprintf(stderr, "kernel_launch: occupancy query reports %d\n", per_cu);
        (void)hipGetLastError();
        grid = cus;
        if (grid != 256) fprintf(stderr, "kernel_launch: %d CUs (built for 256)\n", grid);
    }
    if (grid < 0) return;
    if (hipMemsetAsync((char*)d_ws + WS_CTL, 0, CTL_ZERO_BYTES, stream) != hipSuccess) return;
    Args a{};
    for (int i = 0; i < 22; ++i) a.in[i] = (const float*)d_in[i];
    a.out = (float*)d_out; a.ws = (unsigned char*)d_ws; a.pad = 0;
#if defined(REPLAY_HI)
    a.ph_lo = 0; a.ph_hi = REPLAY_HI; a.li = 0; hipLaunchKernelGGL(mk_fwd, dim3(grid), dim3(NTHR), LDS_BYTES, stream, a);
    a.ph_lo = 0; a.ph_hi = NPH; a.li = 1; hipLaunchKernelGGL(mk_fwd, dim3(grid), dim3(NTHR), LDS_BYTES, stream, a);
#elif MK_PER_PHASE
    for (int ph = 0; ph < NPH; ++ph) { a.ph_lo = ph; a.ph_hi = ph + 1; a.li = 0; hipLaunchKernelGGL(mk_fwd, dim3(grid), dim3(NTHR), LDS_BYTES, stream, a); }
#else
    a.ph_lo = 0; a.ph_hi = NPH; a.li = 0; hipLaunchKernelGGL(mk_fwd, dim3(grid), dim3(NTHR), LDS_BYTES, stream, a);
#endif
    const hipError_t le = hipPeekAtLastError();
    if (le != hipSuccess) fprintf(stderr, "kernel_launch: launch failed: %s\n", hipGetErrorName(le));
}
```
